# Optimizing an MI355X kernel written in HIP

```python
import math
import jax, jax.numpy as jnp
from jax import lax
import numpy as np

D_MODEL = 1024
BATCH = 8
SEQ = 2048
DEPTH = 1
DEC_BATCH = 128
DEC_SEQ = 1
PAST_LEN = 16384
PAGE_SIZE = 128

N_GLA_HEADS = 4
GLA_DK_HEAD = D_MODEL // (2 * N_GLA_HEADS)
GLA_DV_HEAD = D_MODEL // N_GLA_HEADS
GLA_QK_WIDTH = N_GLA_HEADS * GLA_DK_HEAD
GLA_V_WIDTH = N_GLA_HEADS * GLA_DV_HEAD
GATE_LOW_RANK = 16
GLA_GATE_TAU = 16.0
GLA_CHUNK = 64
D_CONV = D_MODEL
CONV_WIDTH = 3
D_FF = 2816
MACARON_WEIGHT = 0.5
RMS_EPS = 1e-6
N_SUBLAYERS = 3

_O_K = GLA_QK_WIDTH
_O_V = _O_K + GLA_QK_WIDTH
_O_R = _O_V + GLA_V_WIDTH
_O_Z = _O_R + GLA_V_WIDTH
_O_B = _O_Z + GATE_LOW_RANK
_O_C = _O_B + D_CONV
_O_H = _O_C + D_CONV
_O_GA = _O_H + D_CONV
_O_GB = _O_GA + D_MODEL
MIX_IN_WIDTH = _O_GB + D_MODEL
SPLIT_POINTS = (_O_K, _O_V, _O_R, _O_Z, _O_B, _O_C, _O_H, _O_GA, _O_GB)

kernel_name = 'gla_shortconv_macaron_adaln_decoder_step'


def _rmsnorm(x, g):
    x32 = x.astype(jnp.float32)
    y = x32 * lax.rsqrt(jnp.mean(x32 * x32, axis=-1, keepdims=True) + RMS_EPS)
    return (y * g.astype(jnp.float32)).astype(x.dtype)


def _swiglu(h, w_in, w_out):
    gate, up = jnp.split(h @ w_in, 2, axis=-1)
    return (jax.nn.silu(gate) * up) @ w_out


def _gla(q, k, v, log_a, s0):
    n, l = q.shape[0], q.shape[1]
    c = math.gcd(l, GLA_CHUNK)
    nc = l // c

    def to_chunks(t):
        return t.reshape(n, nc, c, N_GLA_HEADS, t.shape[-1]).transpose(1, 0, 3, 2, 4).astype(jnp.float32)

    causal = jnp.tril(jnp.ones((c, c), dtype=bool))[:, :, None]

    def step(s, inp):
        qc, kc, vc, ac = inp
        b = jnp.cumsum(ac, axis=2)
        diff = jnp.where(causal, b[:, :, :, None, :] - b[:, :, None, :, :], -jnp.inf)
        scores = jnp.einsum('nhtk,nhsk,nhtsk->nhts', qc, kc, jnp.exp(diff))
        o = jnp.einsum('nhts,nhsv->nhtv', scores, vc) + jnp.einsum('nhtk,nhkv->nhtv', qc * jnp.exp(b), s)
        b_last = b[:, :, -1:, :]
        s_new = jnp.exp(b_last[:, :, 0, :])[..., None] * s + jnp.einsum('nhsk,nhsv->nhkv', kc * jnp.exp(b_last - b), vc)
        return s_new, o

    s_fin, o = lax.scan(step, s0.astype(jnp.float32), (to_chunks(q), to_chunks(k), to_chunks(v), to_chunks(log_a)))
    o = o.transpose(1, 0, 3, 2, 4).reshape(n, l, N_GLA_HEADS, GLA_DV_HEAD)
    return o, s_fin.astype(s0.dtype)


def _token_mixer(h, s_gla, s_conv, w_mix_in, w_alpha, b_alpha, g_gla_norm, w_conv, w_branch_out, w_mix_out):
    n, l, _ = h.shape
    proj = h @ w_mix_in
    q, k, v, r, z, cb, cc, ch, ga, gb = jnp.split(proj, SPLIT_POINTS, axis=-1)

    def heads(t):
        return t.reshape(n, l, N_GLA_HEADS, -1)

    log_a = jax.nn.log_sigmoid((z @ w_alpha + b_alpha).astype(jnp.float32)) / GLA_GATE_TAU
    o, s_gla_new = _gla(heads(q) * (GLA_DK_HEAD ** -0.5), heads(k), heads(v), heads(log_a), s_gla)
    o = _rmsnorm(o.astype(h.dtype), g_gla_norm.reshape(N_GLA_HEADS, GLA_DV_HEAD)).reshape(n, l, GLA_V_WIDTH)
    y_gla = o * jax.nn.silu(r)

    u = cc * ch
    padded = jnp.concatenate([s_conv.astype(u.dtype), u], axis=1)
    conv = (w_conv[0] * padded[:, 0:l] + w_conv[1] * padded[:, 1:l + 1] + w_conv[2] * padded[:, 2:l + 2])
    s_conv_new = padded[:, l:]
    y_conv = cb * conv

    branches = jnp.stack([y_gla, y_conv], axis=-2)
    proj_b = jnp.einsum('nlbw,bwd->nlbd', branches, w_branch_out)
    gates = jax.nn.sigmoid(jnp.stack([ga, gb], axis=-2))
    merged = jnp.sum(gates * proj_b, axis=-2)
    return merged @ w_mix_out, s_gla_new, s_conv_new


def _decoder_layer(x, c, s_gla, s_conv, w_ada, b_ada, g_pre, g_post, w_ffn1_in, w_ffn1_out,
                   w_ffn2_in, w_ffn2_out, w_mix_in, w_alpha, b_alpha, g_gla_norm, w_conv,
                   w_branch_out, w_mix_out):
    ada = (jax.nn.silu(c) @ w_ada + b_ada).reshape(c.shape[0], N_SUBLAYERS, 3, 1, D_MODEL)
    shift, scale, gate = ada[:, :, 0], ada[:, :, 1], ada[:, :, 2]

    def pre(i, t):
        return _rmsnorm(t, g_pre[i]) * (1.0 + scale[:, i]) + shift[:, i]

    def post(i, t, out, weight):
        return t + weight * gate[:, i] * _rmsnorm(out, g_post[i])

    x = post(0, x, _swiglu(pre(0, x), w_ffn1_in, w_ffn1_out), MACARON_WEIGHT)
    mix, s_gla_new, s_conv_new = _token_mixer(pre(1, x), s_gla, s_conv, w_mix_in, w_alpha, b_alpha,
                                              g_gla_norm, w_conv, w_branch_out, w_mix_out)
    x = post(1, x, mix, 1.0)
    x = post(2, x, _swiglu(pre(2, x), w_ffn2_in, w_ffn2_out), MACARON_WEIGHT)
    return x, s_gla_new, s_conv_new


def setup_inputs(seed: int = 0) -> dict:
    key = jax.random.key(seed)
    ks = jax.random.split(key, 24)

    def nrm(k, shape, scale):
        return jax.random.normal(k, shape, jnp.float32) * scale

    return {
        'x_prompt': nrm(ks[0], (BATCH, SEQ, D_MODEL), 1.0),
        'x_sample': nrm(ks[1], (DEC_BATCH, DEC_SEQ, D_MODEL), 1.0),
        'state_gla': nrm(ks[2], (DEPTH, DEC_BATCH, N_GLA_HEADS, GLA_DK_HEAD, GLA_DV_HEAD), 1.0),
        'state_conv': nrm(ks[3], (DEPTH, DEC_BATCH, CONV_WIDTH - 1, D_CONV), 1.0),
        'c_prompt': nrm(ks[4], (BATCH, D_MODEL), 1.0),
        'c_sample': nrm(ks[5], (DEC_BATCH, D_MODEL), 1.0),
        'w_ada': nrm(ks[6], (DEPTH, D_MODEL, N_SUBLAYERS * 3 * D_MODEL), D_MODEL ** -0.5),
        'b_ada': nrm(ks[7], (DEPTH, N_SUBLAYERS * 3 * D_MODEL), 0.02),
        'g_pre': 1.0 + nrm(ks[8], (DEPTH, N_SUBLAYERS, D_MODEL), 0.02),
        'g_post': 1.0 + nrm(ks[9], (DEPTH, N_SUBLAYERS, D_MODEL), 0.02),
        'w_ffn1_in': nrm(ks[10], (DEPTH, D_MODEL, 2 * D_FF), D_MODEL ** -0.5),
        'w_ffn1_out': nrm(ks[11], (DEPTH, D_FF, D_MODEL), D_FF ** -0.5),
        'w_ffn2_in': nrm(ks[12], (DEPTH, D_MODEL, 2 * D_FF), D_MODEL ** -0.5),
        'w_ffn2_out': nrm(ks[13], (DEPTH, D_FF, D_MODEL), D_FF ** -0.5),
        'w_mix_in': nrm(ks[14], (DEPTH, D_MODEL, MIX_IN_WIDTH), D_MODEL ** -0.5),
        'w_alpha': nrm(ks[15], (DEPTH, GATE_LOW_RANK, GLA_QK_WIDTH), GATE_LOW_RANK ** -0.5),
        'b_alpha': nrm(ks[16], (DEPTH, GLA_QK_WIDTH), 0.02),
        'g_gla_norm': 1.0 + nrm(ks[17], (DEPTH, GLA_V_WIDTH), 0.02),
        'w_conv': nrm(ks[18], (DEPTH, CONV_WIDTH, D_CONV), CONV_WIDTH ** -0.5),
        'w_branch_out': nrm(ks[19], (DEPTH, 2, D_MODEL, D_MODEL), D_MODEL ** -0.5),
        'w_mix_out': nrm(ks[20], (DEPTH, D_MODEL, D_MODEL), D_MODEL ** -0.5),
    }


def reference(x_prompt, x_sample, state_gla, state_conv, c_prompt, c_sample, w_ada, b_ada, g_pre,
              g_post, w_ffn1_in, w_ffn1_out, w_ffn2_in, w_ffn2_out, w_mix_in, w_alpha, b_alpha,
              g_gla_norm, w_conv, w_branch_out, w_mix_out):
    yp, ys = x_prompt, x_sample
    n_p = x_prompt.shape[0]
    gla_p, conv_p, gla_s, conv_s = [], [], [], []
    for i in range(DEPTH):
        wl = (w_ada[i], b_ada[i], g_pre[i], g_post[i], w_ffn1_in[i], w_ffn1_out[i], w_ffn2_in[i],
              w_ffn2_out[i], w_mix_in[i], w_alpha[i], b_alpha[i], g_gla_norm[i], w_conv[i],
              w_branch_out[i], w_mix_out[i])
        s_gla0 = jnp.zeros((n_p, N_GLA_HEADS, GLA_DK_HEAD, GLA_DV_HEAD), x_prompt.dtype)
        s_conv0 = jnp.zeros((n_p, CONV_WIDTH - 1, D_CONV), x_prompt.dtype)
        yp, sg, sc = _decoder_layer(yp, c_prompt, s_gla0, s_conv0, *wl)
        gla_p.append(sg)
        conv_p.append(sc)
        ys, sg, sc = _decoder_layer(ys, c_sample, state_gla[i], state_conv[i], *wl)
        gla_s.append(sg)
        conv_s.append(sc)
    return (yp, ys, jnp.stack(gla_p), jnp.stack(conv_p), jnp.stack(gla_s), jnp.stack(conv_s))
```

```cpp
#include <hip/hip_runtime.h>
#include <cstdint>
#include <hip/hip_cooperative_groups.h>
#include <cstdio>
namespace cg = cooperative_groups;
#include <cstdlib>

typedef unsigned short bf16_t;
constexpr int D = 1024, NP = 8, T = 2048, NS = 128, MP = NP * T, MT = MP + NS, R = 16640;
constexpr int FF = 2816, MIXW = 8208, NADA = 9216;
constexpr int NH = 4, DK = 128, DV = 256;
constexpr float EPS = 1e-6f;
constexpr int O_Q = 0, O_K = 512, O_V = 1024, O_R = 2048, O_Z = 3072, O_B = 3088, O_C = 4112, O_H = 5136, O_GA = 6160, O_GB = 7184;
constexpr size_t OUT_Y = 0, OUT_GLA_P = (size_t)MT * D, OUT_CONV_P = OUT_GLA_P + (size_t)NP * NH * DK * DV,
                 OUT_GLA_S = OUT_CONV_P + (size_t)NP * 2 * D, OUT_CONV_S = OUT_GLA_S + (size_t)NS * NH * DK * DV;
constexpr size_t MiB = 1u << 20;
constexpr size_t WS_CTL = 0, WS_ADA = 1 * MiB, WS_Z = 6 * MiB, WS_WB = 8 * MiB;
constexpr size_t SLAB = (size_t)R * D * 2;
constexpr size_t WS_XN = WS_WB + 73 * MiB, WS_S0 = WS_XN + SLAB, WS_S1 = WS_S0 + SLAB, WS_S2 = WS_S1 + SLAB, WS_S3 = WS_S2 + SLAB, WS_S4 = WS_S3 + SLAB,
                 WS_END = WS_S4 + SLAB;
constexpr size_t WS_HID = WS_S0, WS_Y = WS_S4;

__device__ __forceinline__ float bf2f(bf16_t b) { return __uint_as_float((unsigned)b << 16); }
__device__ __forceinline__ bf16_t f2bf(float f) { unsigned u = __float_as_uint(f); return (bf16_t)((u + 0x7fffu + ((u >> 16) & 1u)) >> 16); }
__device__ __forceinline__ float silu_f(float x) { return x / (1.f + __expf(-x)); }
__device__ __forceinline__ float sigmoid_f(float x) { return 1.f / (1.f + __expf(-x)); }
__device__ __forceinline__ float logsig_f(float x) { return fminf(x, 0.f) - log1pf(expf(-fabsf(x))); }
__device__ __forceinline__ float wave_sum(float v) {
#pragma unroll
    for (int o = 1; o < 64; o <<= 1) v += __shfl_xor(v, o);
    return v;
}


typedef float wt_f4 __attribute__((ext_vector_type(4)));
typedef unsigned wt_u4 __attribute__((ext_vector_type(4)));
typedef unsigned wt_u2 __attribute__((ext_vector_type(2)));
__device__ __forceinline__ void st_wt(float* p, wt_f4 v) { asm volatile("global_store_dwordx4 %0, %1, off sc1\n\ts_nop 1" :: "v"(p), "v"(v) : "memory"); }
__device__ __forceinline__ void st_wt(void* p, wt_u4 v) { asm volatile("global_store_dwordx4 %0, %1, off sc1\n\ts_nop 1" :: "v"(p), "v"(v) : "memory"); }
__device__ __forceinline__ void st_wt(void* p, wt_u2 v) { asm volatile("global_store_dwordx2 %0, %1, off sc1\n\ts_nop 1" :: "v"(p), "v"(v) : "memory"); }
struct P {
    const float *x_prompt, *x_sample, *state_gla, *state_conv, *c_prompt, *c_sample, *w_ada, *b_ada, *g_pre, *g_post, *w_ffn1_in, *w_ffn1_out, *w_ffn2_in, *w_ffn2_out,
        *w_mix_in, *w_alpha, *b_alpha, *g_gla, *w_conv, *w_branch, *w_mix_out;
    float* out; unsigned char* ws;
};

constexpr int NWAVES_N = 8;
typedef float nf4 __attribute__((ext_vector_type(4)));
typedef unsigned nu2 __attribute__((ext_vector_type(2)));
struct NormRow { nf4 x[4]; nu2 xb[4]; nu2 y[4]; };
template <int MODE>
__device__ __forceinline__ void norm_load(const P& p, int m, int lane, NormRow& r) {
    if (MODE <= 1) {
        const float* xsrc = m < MP ? p.x_prompt + (size_t)m * D : p.x_sample + (size_t)(m - MP) * D;
#pragma unroll
        for (int j = 0; j < 4; ++j) r.x[j] = __builtin_nontemporal_load((const nf4*)(xsrc + 4 * lane + 256 * j));
    } else {
        const bf16_t* xsrc = (MODE == 2 ? (const bf16_t*)(p.out + OUT_Y) : (const bf16_t*)(p.ws + WS_S3)) + (size_t)m * D;
#pragma unroll
        for (int j = 0; j < 4; ++j) r.xb[j] = __builtin_nontemporal_load((const nu2*)(xsrc + 4 * lane + 256 * j));
    }
    if (MODE >= 1) {
        const bf16_t* y = (const bf16_t*)(p.ws + WS_Y) + (size_t)m * D;
#pragma unroll
        for (int j = 0; j < 4; ++j) r.y[j] = __builtin_nontemporal_load((const nu2*)(y + 4 * lane + 256 * j));
    }
}
template <int MODE>
__device__ __forceinline__ void norm_vecs(const P& p, int ar, int lane, nf4 (&gw)[4], nf4 (&scl)[4], nf4 (&sh)[4]) {
    const float* ada = (const float*)(p.ws + WS_ADA) + (size_t)ar * NADA;
#pragma unroll
    for (int j = 0; j < 4; ++j) {
        if (MODE >= 1) gw[j] = *(const nf4*)(ada + (3 * (MODE - 1) + 2) * D + 4 * lane + 256 * j);
        if (MODE <= 2) { scl[j] = *(const nf4*)(ada + (3 * MODE + 1) * D + 4 * lane + 256 * j); sh[j] = *(const nf4*)(ada + (3 * MODE + 0) * D + 4 * lane + 256 * j); }
    }
}
template <int MODE>
__device__ __forceinline__ void norm_compute(const P& p, int m, int lane, const NormRow& r, const nf4 (&gw)[4], const nf4 (&scl)[4], const nf4 (&sh)[4], const __attribute__((address_space(3))) float* wzt) {
    nf4 xv[4];
#pragma unroll
    for (int j = 0; j < 4; ++j) xv[j] = (MODE <= 1) ? r.x[j] : (nf4){__uint_as_float(r.xb[j].x << 16), __uint_as_float(r.xb[j].x & 0xffff0000u), __uint_as_float(r.xb[j].y << 16), __uint_as_float(r.xb[j].y & 0xffff0000u)};
    if (MODE >= 1) {
        nf4 yv[4]; float ss = 0.f;
#pragma unroll
        for (int j = 0; j < 4; ++j) { yv[j] = (nf4){__uint_as_float(r.y[j].x << 16), __uint_as_float(r.y[j].x & 0xffff0000u), __uint_as_float(r.y[j].y << 16), __uint_as_float(r.y[j].y & 0xffff0000u)};
            ss += (yv[j].x * yv[j].x + yv[j].y * yv[j].y) + (yv[j].z * yv[j].z + yv[j].w * yv[j].w); }
        const float rs = rsqrtf(wave_sum(ss) * (1.f / D) + EPS);
#pragma unroll
        for (int j = 0; j < 4; ++j) { xv[j] += gw[j] * (yv[j] * rs);
            if (MODE == 3) __builtin_nontemporal_store(xv[j], (nf4*)(p.out + OUT_Y + (size_t)m * D + 4 * lane + 256 * j));
            else { nu2 t; t.x = (unsigned)f2bf(xv[j].x) | ((unsigned)f2bf(xv[j].y) << 16); t.y = (unsigned)f2bf(xv[j].z) | ((unsigned)f2bf(xv[j].w) << 16);
                __builtin_nontemporal_store(t, (nu2*)((MODE == 1 ? (bf16_t*)(p.out + OUT_Y) : (bf16_t*)(p.ws + WS_S3)) + (size_t)m * D + 4 * lane + 256 * j)); } }
    }
    if (MODE <= 2) {
        float ss = 0.f;
#pragma unroll
        for (int j = 0; j < 4; ++j) ss += (xv[j].x * xv[j].x + xv[j].y * xv[j].y) + (xv[j].z * xv[j].z + xv[j].w * xv[j].w);
        const float rs = rsqrtf(wave_sum(ss) * (1.f / D) + EPS);
        nf4 hv[4];
        bf16_t* xn = (bf16_t*)(p.ws + WS_XN) + (size_t)m * D;
#pragma unroll
        for (int j = 0; j < 4; ++j) {
            hv[j] = xv[j] * rs * scl[j] + sh[j];
            nu2 t; t.x = (unsigned)f2bf(hv[j].x) | ((unsigned)f2bf(hv[j].y) << 16); t.y = (unsigned)f2bf(hv[j].z) | ((unsigned)f2bf(hv[j].w) << 16);
            st_wt((void*)(xn + 4 * lane + 256 * j), t); }
        if (MODE == 1) {
            float zq[16];
#pragma unroll
            for (int q = 0; q < 16; ++q) {
                float s = 0.f;
#pragma unroll
                for (int j = 0; j < 4; ++j) { const nf4 w = *(const __attribute__((address_space(3))) nf4*)(wzt + q * D + 4 * lane + 256 * j); s += (hv[j].x * w.x + hv[j].y * w.y) + (hv[j].z * w.z + hv[j].w * w.w); }
                zq[q] = s;
                if ((q & 3) == 3) __builtin_amdgcn_sched_barrier(0);
            }
            const bool b5 = (lane >> 5) & 1, b4 = (lane >> 4) & 1, b3 = (lane >> 3) & 1, b2 = (lane >> 2) & 1;
#pragma unroll
            for (int i2 = 0; i2 < 8; ++i2) { const float keep = b5 ? zq[i2 + 8] : zq[i2], send = b5 ? zq[i2] : zq[i2 + 8]; zq[i2] = keep + __shfl_xor(send, 32); }
#pragma unroll
            for (int i2 = 0; i2 < 4; ++i2) { const float keep = b4 ? zq[i2 + 4] : zq[i2], send = b4 ? zq[i2] : zq[i2 + 4]; zq[i2] = keep + __shfl_xor(send, 16); }
#pragma unroll
            for (int i2 = 0; i2 < 2; ++i2) { const float keep = b3 ? zq[i2 + 2] : zq[i2], send = b3 ? zq[i2] : zq[i2 + 2]; zq[i2] = keep + __shfl_xor(send, 8); }
            { const float keep = b2 ? zq[1] : zq[0], send = b2 ? zq[0] : zq[1]; zq[0] = keep + __shfl_xor(send, 4); }
            zq[0] += __shfl_xor(zq[0], 2); zq[0] += __shfl_xor(zq[0], 1);
            if ((lane & 3) == 0) ((float*)(p.ws + WS_Z))[(size_t)m * 16 + (int)b2 + 2 * (int)b3 + 4 * (int)b4 + 8 * (int)b5] = zq[0];
        }
    }
}
template <int MODE>
__device__ __forceinline__ void norm_phase(const P& p, int wave, int lane, const __attribute__((address_space(3))) float* wzt, unsigned* wait_cnt = nullptr, unsigned wait_target = 0u, int shift = 0) {
    const int b = (int)blockIdx.x, G = (int)gridDim.x;
    nf4 gw[4], scl[4], sh[4];
    int r0, cnt;
    if (G == 256) { if (b < 192) { cnt = 64 + shift; r0 = b * cnt; } else { cnt = 64 - 3 * shift; r0 = 192 * (64 + shift) + (b - 192) * cnt; } }
    else { const int per = (MP + G - 1) / G; r0 = b * per; cnt = (r0 + per <= MP) ? per : (MP > r0 ? MP - r0 : 0); }
    {
        int cur_ar = -1;
        NormRow cur, nxt;
        int m = r0 + wave;
        if (m < r0 + cnt) norm_load<MODE>(p, m, lane, cur);
#pragma unroll 1
        for (; m < r0 + cnt; m += 8) {
            if (m + 8 < r0 + cnt) norm_load<MODE>(p, m + 8, lane, nxt);
            if ((m >> 11) != cur_ar) { cur_ar = m >> 11; norm_vecs<MODE>(p, cur_ar, lane, gw, scl, sh); }
            norm_compute<MODE>(p, m, lane, cur, gw, scl, sh, wzt);
            cur = nxt;
        }
    }
    for (int s = b * NWAVES_N + wave; s < NS; s += (int)gridDim.x * NWAVES_N) {
        if (wait_cnt) {
            if (lane == 0) while (__hip_atomic_load(wait_cnt, __ATOMIC_RELAXED, __HIP_MEMORY_SCOPE_AGENT) < wait_target) __builtin_amdgcn_s_sleep(16);
            __builtin_amdgcn_fence(__ATOMIC_ACQUIRE, "agent");
            asm volatile("s_waitcnt vmcnt(0)" ::: "memory");
        }
        NormRow cur;
        norm_vecs<MODE>(p, NP + s, lane, gw, scl, sh);
        norm_load<MODE>(p, MP + s, lane, cur);
        norm_compute<MODE>(p, MP + s, lane, cur, gw, scl, sh, wzt);
    }
}

namespace pg8 {
#define PG8_LAS __attribute__((address_space(3)))
typedef unsigned short bf16_t;
typedef short bf16x8 __attribute__((ext_vector_type(8)));
typedef float f32x4 __attribute__((ext_vector_type(4)));
typedef unsigned u32x4 __attribute__((ext_vector_type(4)));
constexpr int BM = 256, BK = 64, HALF = 128, HTB = HALF * BK * 2  , STAGE_BYTES = 8 * HTB, NXCD = 8, WGM = 8;

__host__ __device__ __forceinline__ int lds_byte(int r, int c) { const int st = (r >> 4) * 2 + (c >> 5), rr = r & 15, cc = c & 31, ob = rr * 64 + cc * 2; return st * 1024 + (ob ^ (((ob >> 9) & 1) << 5)); }
__host__ __device__ __forceinline__ void stage_rc(int b, int& R, int& C) { const int st = b / 1024, sb = b % 1024, swz = sb ^ (((sb >> 9) & 1) << 5); R = (st >> 1) * 16 + swz / 64; C = (st & 1) * 32 + (swz % 64) / 2; }
__host__ __device__ __forceinline__ int perm32(int rho) { const int n = rho >> 4, i = rho & 15; return 8 * (i >> 2) + 4 * n + (i & 3); }

struct Unit { int pm, pn; };
struct Gemm { const bf16_t* A; const bf16_t* Bt; int M, N, K; };

struct StaticOrder {
    int nM, nN, nwg, G, c;
    __host__ __device__ void init(int M, int N, int G_, int c_) { nM = M / BM; nN = N / BM; nwg = nM * nN; G = G_; c = c_; }
    __host__ __device__ bool next(int i, Unit& u) const {
        const long L = (long)i * G + c; if (L >= nwg) return false;
        int wgid = (int)L; { const int q = nwg / NXCD, r = nwg % NXCD, xcd = wgid % NXCD, off = wgid / NXCD; wgid = (xcd < r ? xcd * (q + 1) : r * (q + 1) + (xcd - r) * q) + off; }
        const int nig = WGM * nN, gid = wgid / nig, fm = gid * WGM, gsz = (nM - fm) < WGM ? (nM - fm) : WGM;
        u.pm = fm + ((wgid % nig) % gsz); u.pn = (wgid % nig) / gsz; return true;
    }
    __device__ __forceinline__ void a_ready(const Unit&) const {}
    __device__ __forceinline__ void done(const Unit&) const {}
};


__device__ __forceinline__ unsigned cvt_pk_bf16(float lo, float hi) { unsigned r; asm volatile("v_cvt_pk_bf16_f32 %0, %1, %2" : "=v"(r) : "v"(lo), "v"(hi)); return r; }
__device__ __forceinline__ float e_sigmoid(float x) { return __builtin_amdgcn_rcpf(1.f + __expf(-x)); }
__device__ __forceinline__ float e_silu(float x) { return x * e_sigmoid(x); }
__device__ __forceinline__ float bfl(unsigned w) { return __uint_as_float(w << 16); }
__device__ __forceinline__ float bfh(unsigned w) { return __uint_as_float(w & 0xffff0000u); }
enum { K_SWIGLU = 0, K_MIXA, K_MIXB, K_PLAIN, K_GATE0, K_GATE1, K_ADA };
template <int KIND> struct EpiGen {
    static constexpr bool PERM = true, AFTER_DRAIN = false;
    unsigned char* ws; int pn_off;
    __device__ __forceinline__ static void st8(bf16_t* p, const f32x4 a, const f32x4 b) {
        u32x4 w; w.x = cvt_pk_bf16(a[0], a[1]); w.y = cvt_pk_bf16(a[2], a[3]); w.z = cvt_pk_bf16(b[0], b[1]); w.w = cvt_pk_bf16(b[2], b[3]); *(u32x4*)p = w; }
    __device__ __forceinline__ void operator()(const f32x4 (&acc)[2][2][4][2], const Unit& u, int wr, int wc, int fr, int fq) const {
        const int row0 = u.pm * BM + wr * 64 + fr, cw = wc * 32 + 8 * fq, pn = u.pn + pn_off;
#pragma unroll
        for (int ai = 0; ai < 2; ++ai)
#pragma unroll
            for (int m = 0; m < 4; ++m) {
                const size_t row = (size_t)(row0 + ai * HALF + m * 16);
                if (KIND == K_SWIGLU || (KIND == K_MIXB && pn >= 4 && pn < 12)) {
                    f32x4 o0, o1;
#pragma unroll
                    for (int e = 0; e < 4; ++e) {
                        const float a0 = acc[ai][0][m][0][e], a1 = acc[ai][0][m][1][e], b0 = acc[ai][1][m][0][e], b1 = acc[ai][1][m][1][e];
                        o0[e] = (KIND == K_SWIGLU ? e_silu(a0) : a0) * b0; o1[e] = (KIND == K_SWIGLU ? e_silu(a1) : a1) * b1; }
                    bf16_t* d = (KIND == K_SWIGLU) ? (bf16_t*)(ws + WS_HID) + row * FF + 128 * pn + cw : (bf16_t*)(ws + WS_S4) + row * D + 128 * (pn - 4) + cw;
                    st8(d, o0, o1);
                } else {
#pragma unroll
                    for (int bj = 0; bj < 2; ++bj) {
                        f32x4 v0 = acc[ai][bj][m][0], v1 = acc[ai][bj][m][1];
                        bf16_t* d;
                        if (KIND == K_MIXA) {
                            d = (bf16_t*)(ws + WS_S0 + (size_t)(pn >> 2) * SLAB) + row * D + 256 * (pn & 3) + 128 * bj + cw;
                            if (pn < 2) { v0 = v0 * 0.08838834764831845f; v1 = v1 * 0.08838834764831845f; }
                            else if (pn >= 8) {
#pragma unroll
                                for (int e = 0; e < 4; ++e) { v0[e] = e_silu(v0[e]); v1[e] = e_silu(v1[e]); } }
                        } else if (KIND == K_MIXB) {
                            if (pn < 4) d = (bf16_t*)(ws + WS_S3) + row * D + 256 * pn + 128 * bj + cw;
                            else {
                                d = (bf16_t*)(ws + (pn < 16 ? WS_S0 : WS_S1)) + row * D + 256 * ((pn - 12) & 3) + 128 * bj + cw;
#pragma unroll
                                for (int e = 0; e < 4; ++e) { v0[e] = e_sigmoid(v0[e]); v1[e] = e_sigmoid(v1[e]); } }
                        } else if (KIND == K_PLAIN) {
                            d = (bf16_t*)(ws + WS_Y) + row * D + 256 * pn + 128 * bj + cw;
                        } else {
                            const size_t off = row * D + 256 * pn + 128 * bj + cw;
                            bf16_t* pa = (bf16_t*)(ws + WS_S0) + off; bf16_t* pb = (bf16_t*)(ws + WS_S1) + off;
                            const u32x4 ga = *(const u32x4*)pa;
                            if (KIND == K_GATE0) {
                                v0[0] *= bfl(ga.x); v0[1] *= bfh(ga.x); v0[2] *= bfl(ga.y); v0[3] *= bfh(ga.y); v1[0] *= bfl(ga.z); v1[1] *= bfh(ga.z); v1[2] *= bfl(ga.w); v1[3] *= bfh(ga.w);
                                d = pa;
                            } else {
                                const u32x4 gb = *(const u32x4*)pb;
                                v0[0] = bfl(ga.x) + bfl(gb.x) * v0[0]; v0[1] = bfh(ga.x) + bfh(gb.x) * v0[1]; v0[2] = bfl(ga.y) + bfl(gb.y) * v0[2]; v0[3] = bfh(ga.y) + bfh(gb.y) * v0[3];
                                v1[0] = bfl(ga.z) + bfl(gb.z) * v1[0]; v1[1] = bfh(ga.z) + bfh(gb.z) * v1[1]; v1[2] = bfl(ga.w) + bfl(gb.w) * v1[2]; v1[3] = bfh(ga.w) + bfh(gb.w) * v1[3];
                                d = pb;
                            }
                        }
                        st8(d, v0, v1);
                    }
                }
            }
    }
};

template <class Epi, class Sched, bool ALIGN_EPI = false, bool SP2 = false>
__device__ __forceinline__ void gemm_phase(PG8_LAS unsigned char* lds, const Gemm g, const Sched& S, const Epi& E) {
    const int tid = threadIdx.x, wid = __builtin_amdgcn_readfirstlane(tid >> 6), lane = tid & 63, wr = wid >> 2, wc = wid & 3, fr = lane & 15, fq = lane >> 4;
    const int K = g.K, nt = K / BK;
    unsigned voffA[2], voffB[2];
#pragma unroll
    for (int i = 0; i < 2; ++i) { int R, C; stage_rc(tid * 16 + i * 8192, R, C); const int Rb = Epi::PERM ? ((R & ~31) + perm32(R & 31)) : R;
        voffA[i] = (unsigned)(R * K + C) * 2u; voffB[i] = (unsigned)(Rb * K + C) * 2u; }
    const size_t kstep = (size_t)(BK * 2);
    const size_t hstep = (size_t)HALF * K * 2;
    const size_t tstep = 2 * hstep;
    const unsigned ldsw = (unsigned)wid * 1024u;
    const int aoff = lds_byte(wr * 64 + fr, fq * 8), boff = lds_byte(wc * 32 + fr, fq * 8);
#define PG8_SA(b, h) (((b) * 2 + (h)) * HTB)
#define PG8_SB(b, h) ((4 + (b) * 2 + (h)) * HTB)
#define PG8_STAGE(bufoff, gbase, voff) do { _Pragma("unroll") for (int _i = 0; _i < 2; ++_i) \
        __builtin_amdgcn_global_load_lds((const unsigned*)((const char*)(gbase) + (voff)[_i]), (PG8_LAS unsigned*)(lds + (bufoff) + ldsw + _i * 8192), 16, 0, 0); } while (0)
#define PG8_LDA(dst, b, h) do { _Pragma("unroll") for (int m = 0; m < 4; ++m) _Pragma("unroll") for (int k = 0; k < 2; ++k) dst[m][k] = *(const PG8_LAS bf16x8*)(lds + PG8_SA(b, h) + aoff + m * 2048 + k * 1024); } while (0)
#define PG8_LDB(dst, b, h) do { _Pragma("unroll") for (int n = 0; n < 2; ++n) _Pragma("unroll") for (int k = 0; k < 2; ++k) dst[n][k] = *(const PG8_LAS bf16x8*)(lds + PG8_SB(b, h) + boff + n * 2048 + k * 1024); } while (0)
#define PG8_MMA(ai, bj, At, Bt) do { __builtin_amdgcn_s_setprio(1); _Pragma("unroll") for (int m = 0; m < 4; ++m) _Pragma("unroll") for (int n = 0; n < 2; ++n) _Pragma("unroll") for (int k = 0; k < 2; ++k) \
        acc[ai][bj][m][n] = __builtin_amdgcn_mfma_f32_16x16x32_bf16(Bt[n][k], At[m][k], acc[ai][bj][m][n], 0, 0, 0); __builtin_amdgcn_s_setprio(0); } while (0)
#define PG8_WAIT_V(n) asm volatile("s_waitcnt vmcnt(" #n ")" ::: "memory")
#define PG8_WAIT_L(n) asm volatile("s_waitcnt lgkmcnt(" #n ")" ::: "memory")
#define PG8_BAR __builtin_amdgcn_s_barrier()
#define PG8_SCHED __builtin_amdgcn_sched_barrier(0)
    Unit cur, nxt; int ui = 0;
    if (!S.next(0, cur)) return;
    f32x4 acc[2][2][4][2];
#pragma unroll
    for (int a = 0; a < 2; ++a)
#pragma unroll
        for (int b = 0; b < 2; ++b)
#pragma unroll
            for (int m = 0; m < 4; ++m)
#pragma unroll
                for (int n = 0; n < 2; ++n) acc[a][b][m][n] = (f32x4){0.f, 0.f, 0.f, 0.f};
    bf16x8 At[4][2], B0[2][2], B1[2][2];
    const char* cA = (const char*)g.A + (size_t)cur.pm * tstep; const char* cB = (const char*)g.Bt + (size_t)cur.pn * tstep;
    S.a_ready(cur);
    if constexpr (SP2) {
        PG8_STAGE(PG8_SB(0, 0), cB, voffB); PG8_STAGE(PG8_SB(0, 1), cB + hstep, voffB); PG8_STAGE(PG8_SA(0, 0), cA, voffA); PG8_STAGE(PG8_SA(0, 1), cA + hstep, voffA);
        if (wr == 1) PG8_BAR;
        PG8_WAIT_V(2); PG8_BAR;
        PG8_STAGE(PG8_SB(1, 0), cB + kstep, voffB); PG8_STAGE(PG8_SA(1, 0), cA + kstep, voffA); PG8_STAGE(PG8_SB(1, 1), cB + hstep + kstep, voffB);
        PG8_WAIT_V(6); PG8_BAR;
    } else {
        PG8_STAGE(PG8_SB(0, 0), cB, voffB); PG8_STAGE(PG8_SA(0, 0), cA, voffA); PG8_STAGE(PG8_SB(0, 1), cB + hstep, voffB); PG8_STAGE(PG8_SA(0, 1), cA + hstep, voffA);
        if (wr == 1) PG8_BAR;
        PG8_WAIT_V(4); PG8_BAR;
        PG8_STAGE(PG8_SB(1, 0), cB + kstep, voffB); PG8_STAGE(PG8_SA(1, 0), cA + kstep, voffA); PG8_STAGE(PG8_SB(1, 1), cB + hstep + kstep, voffB);
        PG8_WAIT_V(6); PG8_BAR;
    }
    for (;;) {
        const bool has_next = S.next(ui + 1, nxt);
        const char* nA = has_next ? (const char*)g.A + (size_t)nxt.pm * tstep : cA; const char* nB = has_next ? (const char*)g.Bt + (size_t)nxt.pn * tstep : cB;
        for (int t = 0; t < nt; t += 2) {
            const bool last = (t == nt - 2);
            const char* a1 = cA + (size_t)(t + 1) * kstep;
            const char* a2 = last ? nA : cA + (size_t)(t + 2) * kstep; const char* b2 = last ? nB : cB + (size_t)(t + 2) * kstep;
            const char* a3 = a2 + kstep; const char* b3 = b2 + kstep;
            if (last && has_next) S.a_ready(nxt);
            if constexpr (SP2) {
            PG8_LDB(B0, 0, 0); PG8_LDB(B1, 0, 1); PG8_SCHED; PG8_LDA(At, 0, 0); PG8_STAGE(PG8_SA(1, 1), a1 + hstep, voffA);
            PG8_WAIT_V(8); PG8_WAIT_L(0); PG8_BAR; PG8_MMA(0, 0, At, B0); PG8_MMA(0, 1, At, B1); PG8_BAR; PG8_SCHED;
            PG8_LDA(At, 0, 1); PG8_STAGE(PG8_SB(0, 0), b2, voffB); PG8_STAGE(PG8_SB(0, 1), b2 + hstep, voffB); PG8_STAGE(PG8_SA(0, 0), a2, voffA);
            PG8_WAIT_V(8); PG8_WAIT_L(0); PG8_BAR; PG8_MMA(1, 0, At, B0); PG8_MMA(1, 1, At, B1); PG8_BAR; PG8_SCHED;
            PG8_LDB(B0, 1, 0); PG8_LDB(B1, 1, 1); PG8_SCHED; PG8_LDA(At, 1, 0); PG8_STAGE(PG8_SA(0, 1), a2 + hstep, voffA);
            PG8_WAIT_V(8); PG8_WAIT_L(0); PG8_BAR; PG8_MMA(0, 0, At, B0); PG8_MMA(0, 1, At, B1); PG8_BAR; PG8_SCHED;
            PG8_LDA(At, 1, 1); PG8_STAGE(PG8_SB(1, 0), b3, voffB); PG8_STAGE(PG8_SB(1, 1), b3 + hstep, voffB); PG8_STAGE(PG8_SA(1, 0), a3, voffA);
            PG8_WAIT_V(8); PG8_WAIT_L(0); PG8_BAR; PG8_MMA(1, 0, At, B0); PG8_MMA(1, 1, At, B1); PG8_BAR; PG8_SCHED;
            } else {
            PG8_LDB(B0, 0, 0); PG8_SCHED; PG8_LDA(At, 0, 0); PG8_STAGE(PG8_SA(1, 1), a1 + hstep, voffA);
            PG8_WAIT_L(8); PG8_BAR; PG8_WAIT_L(0); PG8_MMA(0, 0, At, B0); PG8_BAR; PG8_SCHED;
            PG8_LDB(B1, 0, 1); PG8_STAGE(PG8_SB(0, 0), b2, voffB);
            PG8_BAR; PG8_WAIT_L(0); PG8_MMA(0, 1, At, B1); PG8_BAR;
            PG8_LDA(At, 0, 1); PG8_STAGE(PG8_SA(0, 0), a2, voffA);
            PG8_BAR; PG8_WAIT_L(0); PG8_MMA(1, 0, At, B0); PG8_BAR; PG8_SCHED;
            PG8_STAGE(PG8_SB(0, 1), b2 + hstep, voffB);
            PG8_WAIT_V(6); PG8_BAR; PG8_MMA(1, 1, At, B1); PG8_BAR;
            PG8_LDB(B0, 1, 0); PG8_SCHED; PG8_LDA(At, 1, 0); PG8_STAGE(PG8_SA(0, 1), a2 + hstep, voffA);
            PG8_WAIT_L(8); PG8_BAR; PG8_WAIT_L(0); PG8_MMA(0, 0, At, B0); PG8_BAR; PG8_SCHED;
            PG8_LDB(B1, 1, 1); PG8_STAGE(PG8_SB(1, 0), b3, voffB);
            PG8_BAR; PG8_WAIT_L(0); PG8_MMA(0, 1, At, B1); PG8_BAR;
            PG8_LDA(At, 1, 1); PG8_STAGE(PG8_SA(1, 0), a3, voffA);
            PG8_BAR; PG8_WAIT_L(0); PG8_MMA(1, 0, At, B0); PG8_BAR; PG8_SCHED;
            PG8_STAGE(PG8_SB(1, 1), b3 + hstep, voffB);
            PG8_WAIT_V(6); PG8_BAR; PG8_MMA(1, 1, At, B1); PG8_BAR;
            }
        }
        if constexpr (ALIGN_EPI) { if (wr == 0) PG8_BAR; }
        if constexpr (!Epi::AFTER_DRAIN) { E(acc, cur, wr, wc, fr, fq); S.done(cur); }
        if (!has_next) break;
#pragma unroll
        for (int a = 0; a < 2; ++a)
#pragma unroll
            for (int b = 0; b < 2; ++b)
#pragma unroll
                for (int m = 0; m < 4; ++m)
#pragma unroll
                    for (int n = 0; n < 2; ++n) acc[a][b][m][n] = (f32x4){0.f, 0.f, 0.f, 0.f};
        cur = nxt; cA = nA; cB = nB; ++ui;
        if constexpr (ALIGN_EPI) { if (wr == 1) PG8_BAR; }
    }
    PG8_WAIT_V(0);
    if constexpr (!ALIGN_EPI) { if (wr == 0) PG8_BAR; }
    PG8_BAR;
    if constexpr (Epi::AFTER_DRAIN) { E.fused(acc, cur, wr, wc, fr, fq, lds, wid, lane); S.done(cur); }
#undef PG8_SA
#undef PG8_SB
#undef PG8_STAGE
#undef PG8_LDA
#undef PG8_LDB
#undef PG8_MMA
#undef PG8_WAIT_V
#undef PG8_WAIT_L
#undef PG8_BAR
#undef PG8_SCHED
}
}

constexpr int NWAVES = 8, LDS_BYTES = 147456, RING_BYTES = 131072;
constexpr size_t WB_W1IN = 0, WB_W1OUT = WB_W1IN + (size_t)2 * FF * D * 2, WB_W2IN = WB_W1OUT + (size_t)D * FF * 2, WB_W2OUT = WB_W2IN + (size_t)2 * FF * D * 2,
                 WB_MIXA = WB_W2OUT + (size_t)D * FF * 2, WB_MIXB = WB_MIXA + (size_t)3072 * D * 2, WB_BR = WB_MIXB + (size_t)5120 * D * 2, WB_MO = WB_BR + (size_t)2 * D * D * 2,
                 WB_ADA = WB_MO + (size_t)D * D * 2, WB_END = WB_ADA + (size_t)NADA * D * 2;
static_assert(WB_END <= 73 * MiB, "weights region");
#define LAS __attribute__((address_space(3)))
typedef unsigned v4u __attribute__((ext_vector_type(4)));
__device__ __forceinline__ unsigned pk2(float lo, float hi) { return (unsigned)f2bf(lo) | ((unsigned)f2bf(hi) << 16); }
constexpr int TR_SLOT = 64 * 65 * 4;
__device__ __forceinline__ void transpose_item(const float* W, int ldw, int n0, int k0, bf16_t* WT, int K, int drow0, LAS float* scr, int lane) {
    float wv[64];
    const float* wp = W + (size_t)k0 * ldw + n0 + lane;
#pragma unroll
    for (int i = 0; i < 64; ++i) wv[i] = __builtin_nontemporal_load(wp + (size_t)i * ldw);
    __builtin_amdgcn_sched_barrier(0);
#pragma unroll
    for (int i = 0; i < 64; ++i) scr[i * 65 + lane] = wv[i];
    asm volatile("s_waitcnt lgkmcnt(0)" ::: "memory");
    const int c = lane & 7;
#pragma unroll
    for (int j = 0; j < 8; ++j) { const int n = (lane >> 3) + 8 * j; const LAS float* s = scr + (8 * c) * 65 + n;
        v4u o; o.x = pk2(s[0 * 65], s[1 * 65]); o.y = pk2(s[2 * 65], s[3 * 65]); o.z = pk2(s[4 * 65], s[5 * 65]); o.w = pk2(s[6 * 65], s[7 * 65]);
        *(v4u*)(WT + (size_t)(drow0 + n) * K + k0 + 8 * c) = o; }
    asm volatile("s_waitcnt lgkmcnt(0)" ::: "memory");
}
__device__ __forceinline__ void phase_convert(const P& p, LAS unsigned char* lds, int widx, int nw, int wave, int lane, int group) {
    LAS float* scr = (LAS float*)(lds + wave * TR_SLOT);
    unsigned char* wb = p.ws + WS_WB;
    constexpr int I_FIN = (D / 64) * (2 * FF / 64), I_FOUT = (FF / 64) * (D / 64), I_MA = (D / 64) * (3072 / 64), I_MB = (D / 64) * (5120 / 64), I_SQ = (D / 64) * (D / 64);
    if (group < 0) {
        constexpr int I_ADA = (D / 64) * (NADA / 64);
        for (int it = widx; it < I_ADA; it += nw) { const int nb = NADA / 64, kb = it / nb, db = it % nb;
            transpose_item(p.w_ada, NADA, db * 64, kb * 64, (bf16_t*)(wb + WB_ADA), D, db * 64, scr, lane); }
        return;
    }
    const int nitems = group == 0 ? I_FIN : group == 1 ? I_FOUT + I_MA + I_MB : I_FIN + I_FOUT + 3 * I_SQ;
    for (int it = widx; it < nitems; it += nw) {
        int r = it;
        if (group != 1) {
            if (r < I_FIN) {
                const int which = group == 2; const int nb = 2 * FF / 64, kb = r / nb, db = r % nb, v = db * 64, tile = v >> 8, w = v & 255;
                const int n0 = (w < 128) ? 128 * tile + w : FF + 128 * tile + (w - 128);
                transpose_item(which ? p.w_ffn2_in : p.w_ffn1_in, 2 * FF, n0, kb * 64, (bf16_t*)(wb + (which ? WB_W2IN : WB_W1IN)), D, v, scr, lane); continue; }
            r -= I_FIN;
            if (r < I_FOUT) { const int nb = D / 64, kb = r / nb, db = r % nb;
                transpose_item(p.w_ffn2_out, D, db * 64, kb * 64, (bf16_t*)(wb + WB_W2OUT), FF, db * 64, scr, lane); continue; }
            r -= I_FOUT;
            { const int which = r / I_SQ; r -= which * I_SQ; const int nb = D / 64, kb = r / nb, db = r % nb;
              const float* src = which == 0 ? p.w_branch : which == 1 ? p.w_branch + (size_t)D * D : p.w_mix_out;
              bf16_t* dst = (bf16_t*)(wb + (which == 2 ? WB_MO : WB_BR)) + (which == 1 ? (size_t)D * D : 0);
              transpose_item(src, D, db * 64, kb * 64, dst, D, db * 64, scr, lane); }
            continue;
        }
        if (r < I_FOUT) { const int nb = D / 64, kb = r / nb, db = r % nb;
            transpose_item(p.w_ffn1_out, D, db * 64, kb * 64, (bf16_t*)(wb + WB_W1OUT), FF, db * 64, scr, lane); continue; }
        r -= I_FOUT;
        if (r < I_MA) { const int nb = 3072 / 64, kb = r / nb, db = r % nb;
            transpose_item(p.w_mix_in, MIXW, db * 64, kb * 64, (bf16_t*)(wb + WB_MIXA), D, db * 64, scr, lane); continue; }
        r -= I_MA;
        { const int nb = 5120 / 64, kb = r / nb, db = r % nb, v = db * 64; int n0;
            if (v < 1024) n0 = O_B + v;
            else if (v < 3072) { const int t = (v - 1024) >> 8, w = (v - 1024) & 255; n0 = (w < 128) ? O_C + 128 * t + w : O_H + 128 * t + (w - 128); }
            else if (v < 4096) n0 = O_GA + (v - 3072);
            else n0 = O_GB + (v - 4096);
            transpose_item(p.w_mix_in, MIXW, n0, kb * 64, (bf16_t*)(wb + WB_MIXB), D, v, scr, lane); }
    }
}
constexpr int ADA_ROWS = 192;
__device__ __forceinline__ void phase_ada_stage(const P& p, int gtid, int ngt) {
    bf16_t* A = (bf16_t*)(p.ws + WS_Z);
    for (int i = gtid; i < ADA_ROWS * D; i += ngt) {
        const int r = i >> 10, k = i & (D - 1);
        float v = 0.f;
        if (r < NS) v = silu_f(p.c_sample[(size_t)r * D + k]); else if (r < NS + NP) v = silu_f(p.c_prompt[(size_t)(r - NS) * D + k]);
        A[i] = f2bf(v);
    }
}
__device__ __forceinline__ void phase_conv(const P& p, int gtid, int ngt, int idx0, int idx1) {
    typedef unsigned u4_ __attribute__((ext_vector_type(4))); typedef float f4_ __attribute__((ext_vector_type(4)));
    bf16_t* B = (bf16_t*)(p.ws + WS_S3); const bf16_t* U = (const bf16_t*)(p.ws + WS_S4);
    for (int idx = idx0 + gtid; idx < idx1; idx += ngt) {
        const int m = idx >> 7, c = (idx & 127) * 8;
        const size_t e0 = (size_t)m * D + c;
        float u0[8], um1[8], um2[8], bb[8], w0[8], w1[8], w2[8];
        auto unpack = [](const u4_ v, float* f) { f[0] = __uint_as_float(v.x << 16); f[1] = __uint_as_float(v.x & 0xffff0000u); f[2] = __uint_as_float(v.y << 16); f[3] = __uint_as_float(v.y & 0xffff0000u);
                                                 f[4] = __uint_as_float(v.z << 16); f[5] = __uint_as_float(v.z & 0xffff0000u); f[6] = __uint_as_float(v.w << 16); f[7] = __uint_as_float(v.w & 0xffff0000u); };
        auto ld8 = [](const float* s, float* f) { const f4_ a = *(const f4_*)s, b = *(const f4_*)(s + 4); f[0] = a.x; f[1] = a.y; f[2] = a.z; f[3] = a.w; f[4] = b.x; f[5] = b.y; f[6] = b.z; f[7] = b.w; };
        auto st8f = [](float* d, const float* f) { *(f4_*)d = (f4_){f[0], f[1], f[2], f[3]}; *(f4_*)(d + 4) = (f4_){f[4], f[5], f[6], f[7]}; };
        unpack(*(const u4_*)(U + e0), u0); unpack(*(const u4_*)(B + e0), bb);
        ld8(p.w_conv + c, w0); ld8(p.w_conv + D + c, w1); ld8(p.w_conv + 2 * D + c, w2);
        if (m < MP) {
            const int t = m & (T - 1), n = m >> 11;
            const u4_ z4 = (u4_){0u, 0u, 0u, 0u};
            unpack(t >= 1 ? *(const u4_*)(U + e0 - D) : z4, um1);
            unpack(t >= 2 ? *(const u4_*)(U + e0 - 2 * D) : z4, um2);
            if (t >= T - 2) st8f(p.out + OUT_CONV_P + (size_t)(n * 2 + (t - (T - 2))) * D + c, u0);
        } else {
            const int n = m - MP;
            ld8(p.state_conv + (size_t)(n * 2 + 0) * D + c, um2); ld8(p.state_conv + (size_t)(n * 2 + 1) * D + c, um1);
            st8f(p.out + OUT_CONV_S + (size_t)(n * 2 + 0) * D + c, um1);
            st8f(p.out + OUT_CONV_S + (size_t)(n * 2 + 1) * D + c, u0);
        }
        float y[8];
#pragma unroll
        for (int e = 0; e < 8; ++e) y[e] = bb[e] * (w0[e] * um2[e] + w1[e] * um1[e] + w2[e] * u0[e]);
        u4_ o; o.x = pk2(y[0], y[1]); o.y = pk2(y[2], y[3]); o.z = pk2(y[4], y[5]); o.w = pk2(y[6], y[7]);
        *(u4_*)(B + e0) = o;
    }
}
__device__ __forceinline__ void gla_sample_naive_blk(const P& p, LAS float* sm, int nh, int tid) {
    LAS float *q_s = sm, *k_s = sm + DK, *a_s = sm + 2 * DK, *red = sm + 3 * DK, *op = sm + 3 * DK + 8;
    const int n = nh >> 2, h = nh & 3, dv = tid & (DV - 1), half = tid >> 8;
    const bf16_t* QK = (const bf16_t*)(p.ws + WS_S0); const bf16_t* V = (const bf16_t*)(p.ws + WS_S1); bf16_t* RY = (bf16_t*)(p.ws + WS_S2);
    const float* Z = (const float*)(p.ws + WS_Z);
    const size_t m = (size_t)MP + n;
    if (tid < DK) {
        float x = p.b_alpha[h * DK + tid];
        for (int j = 0; j < 16; ++j) x += Z[m * 16 + j] * p.w_alpha[j * 512 + h * DK + tid];
        a_s[tid] = expf(logsig_f(x) * (1.f / 16.f));
        q_s[tid] = bf2f(QK[m * D + h * DK + tid]);
        k_s[tid] = bf2f(QK[m * D + 512 + h * DK + tid]);
    }
    __syncthreads();
    const float v = bf2f(V[m * D + h * DV + dv]);
    const float* s0 = p.state_gla + (size_t)nh * DK * DV + (size_t)(64 * half) * DV + dv;
    float* s1 = p.out + OUT_GLA_S + (size_t)nh * DK * DV + (size_t)(64 * half) * DV + dv;
    float o = 0.f;
#pragma unroll 1
    for (int k8 = 0; k8 < 64; k8 += 16) {
        float sv[16];
#pragma unroll
        for (int e = 0; e < 16; ++e) sv[e] = __builtin_nontemporal_load(s0 + (size_t)(k8 + e) * DV);
#pragma unroll
        for (int e = 0; e < 16; ++e) { const int kk = 64 * half + k8 + e; const float s = a_s[kk] * sv[e] + k_s[kk] * v; __builtin_nontemporal_store(s, s1 + (size_t)(k8 + e) * DV); o += q_s[kk] * s; }
    }
    op[tid] = o;
    __syncthreads();
    float ot = 0.f;
    if (tid < DV) { ot = op[tid] + op[tid + DV]; const float ws_ = wave_sum(ot * ot); if ((tid & 63) == 0) red[tid >> 6] = ws_; }
    __syncthreads();
    if (tid < DV) {
        const float rs = rsqrtf((red[0] + red[1] + red[2] + red[3]) * (1.f / DV) + EPS);
        const size_t idx = m * D + h * DV + tid;
        RY[idx] = f2bf(ot * rs * p.g_gla[h * DV + tid] * bf2f(RY[idx]));
    }
    __syncthreads();
}

typedef float f32x16 __attribute__((ext_vector_type(16)));
typedef short s16x8 __attribute__((ext_vector_type(8)));
typedef short s16x4 __attribute__((ext_vector_type(4)));
typedef float f4 __attribute__((ext_vector_type(4)));
typedef unsigned u4 __attribute__((ext_vector_type(4)));
typedef unsigned u2 __attribute__((ext_vector_type(2)));
__device__ __forceinline__ float logsig_fast(float x) { return fminf(x, 0.f) - __logf(1.f + __expf(-fabsf(x))); }
__device__ __forceinline__ unsigned cvtpk(float lo, float hi) { unsigned r; asm volatile("v_cvt_pk_bf16_f32 %0, %1, %2" : "=v"(r) : "v"(lo), "v"(hi)); return r; }
constexpr size_t WB_PBUF = WB_ADA, WB_DEC = WB_PBUF + (size_t)NP * NH * 32 * 64 * 64 * 2;
static_assert(WB_DEC + (size_t)NP * NH * 32 * 128 * 4 <= WB_END, "P / dec buffers");
namespace gl {
constexpr int QT_LD = 136, KH_LD = 72, P_LD = 72, VT_LD = 72, O_LD = 264;
constexpr int QT_OFF = 0, KT_OFF = QT_OFF + 64 * QT_LD * 2, VT_OFF = KT_OFF + 64 * QT_LD * 2, VT_WAVE = 32 * VT_LD * 2, Z_OFF = VT_OFF + 8 * VT_WAVE, GS_OFF = Z_OFF + 4096, PREP_END = GS_OFF + 2048;
constexpr int B_QT = 0, B_KH = B_QT + 64 * QT_LD * 2, B_P = B_KH + 128 * KH_LD * 2, B_DEC = B_P + 64 * P_LD * 2, BUFSZ = B_DEC + 512, O_OFF = 2 * BUFSZ, G_OFF = O_OFF + 8 * 64 * 40 * 2  , CHAIN_END = G_OFF + 1024 + 4096;
static_assert(PREP_END <= 131072 && CHAIN_END <= 144 * 1024 - 2048, "gla lds map");
}
__device__ __forceinline__ void gla_prep_task(const P& p, LAS unsigned char* lds, int task, int tid, int lane, int wave) {
    using namespace gl;
    const int nh = task >> 5, c = task & 31, n = nh >> 2, h = nh & 3, kk = tid & 127, tg = tid >> 7, l31 = lane & 31, hi = lane >> 5;
    bf16_t* QK = (bf16_t*)(p.ws + WS_S0); bf16_t* V = (bf16_t*)(p.ws + WS_S1);
    const float* Z = (const float*)(p.ws + WS_Z);
    LAS bf16_t* Qt = (LAS bf16_t*)(lds + QT_OFF); LAS bf16_t* Kt = (LAS bf16_t*)(lds + KT_OFF); LAS bf16_t* VTw = (LAS bf16_t*)(lds + VT_OFF + wave * VT_WAVE);
    LAS float* zs = (LAS float*)(lds + Z_OFF); LAS float* gs = (LAS float*)(lds + GS_OFF);
    float wa[16];
#pragma unroll
    for (int j = 0; j < 16; ++j) wa[j] = p.w_alpha[j * 512 + h * DK + kk];
    const float ba = p.b_alpha[h * DK + kk];
    const size_t m0 = (size_t)n * T + 64 * c;
    if (tid < 256) ((LAS f4*)zs)[tid] = ((const f4*)(Z + m0 * 16))[tid];
    unsigned short qv[16], kv[16];
#pragma unroll
    for (int i = 0; i < 16; ++i) { const size_t ro = (m0 + 16 * tg + i) * D + h * DK + kk; qv[i] = QK[ro]; kv[i] = QK[ro + 512]; }
    u4 vr[4];
#pragma unroll
    for (int i = 0; i < 4; ++i) vr[i] = *(const u4*)(V + (m0 + lane) * D + h * DV + 32 * wave + 8 * i);
    __syncthreads();
    float bl[16]; float run = 0.f;
#pragma unroll
    for (int i = 0; i < 16; ++i) {
        const LAS f4* zr = (const LAS f4*)(zs + (16 * tg + i) * 16);
        float x = ba;
#pragma unroll
        for (int j4 = 0; j4 < 4; ++j4) { const f4 zq = zr[j4]; x += zq.x * wa[4 * j4] + zq.y * wa[4 * j4 + 1] + zq.z * wa[4 * j4 + 2] + zq.w * wa[4 * j4 + 3]; }
        run += logsig_fast(x) * (1.f / 16.f); bl[i] = run;
    }
    gs[tg * 128 + kk] = run;
    __syncthreads();
    const float g0 = gs[kk], g1 = gs[128 + kk], g2 = gs[256 + kk], g3 = gs[384 + kk];
    const float off = (tg > 0 ? g0 : 0.f) + (tg > 1 ? g1 : 0.f) + (tg > 2 ? g2 : 0.f);
    const float blast = (g0 + g1) + (g2 + g3);
    unsigned khp[8];
#pragma unroll
    for (int i = 0; i < 16; i += 2) {
        float kh2[2];
#pragma unroll
        for (int e = 0; e < 2; ++e) {
            const int t = 16 * tg + i + e; const float b = bl[i + e] + off;
            const float qf = bf2f(qv[i + e]), kf = bf2f(kv[i + e]);
            Qt[t * QT_LD + kk] = f2bf(qf * __expf(b));
            Kt[t * QT_LD + kk] = f2bf(kf * __expf(-b));
            kh2[e] = kf * __expf(blast - b);
        }
        khp[i >> 1] = cvtpk(kh2[0], kh2[1]);
    }
#pragma unroll
    for (int i = 0; i < 4; ++i) {
        const unsigned w4[4] = {vr[i].x, vr[i].y, vr[i].z, vr[i].w};
#pragma unroll
        for (int e = 0; e < 4; ++e) { VTw[(8 * i + 2 * e) * VT_LD + lane] = (bf16_t)(w4[e] & 0xffffu); VTw[(8 * i + 2 * e + 1) * VT_LD + lane] = (bf16_t)(w4[e] >> 16); }
    }
    __syncthreads();
    { bf16_t* kd = QK + (m0 + (kk >> 1)) * D + 512 + h * DK + (kk & 1) * 64 + 16 * tg;
      *(u4*)kd = (u4){khp[0], khp[1], khp[2], khp[3]}; *(u4*)(kd + 8) = (u4){khp[4], khp[5], khp[6], khp[7]}; }
    if (tg == 0) ((float*)(p.ws + WS_WB + WB_DEC))[(size_t)task * 128 + kk] = __expf(blast);
#pragma unroll
    for (int i = 0; i < 2; ++i) { const int pc = tid + 512 * i, t = pc >> 4, k0 = (pc & 15) * 8;
        *(u4*)(QK + (m0 + t) * D + h * DK + k0) = *(const LAS u4*)(Qt + t * QT_LD + k0); }
#pragma unroll
    for (int i = 0; i < 4; ++i) { const int q = lane + 64 * i, dvl = q >> 3, s0 = (q & 7) * 8, dv = 32 * wave + dvl;
        *(u4*)(V + (m0 + (dv >> 2)) * D + h * DV + (dv & 3) * 64 + s0) = *(const LAS u4*)(VTw + dvl * VT_LD + s0); }
    if (wave < 3) {
        const int ti = wave >= 1, si = wave == 2;
        f32x16 x;
#pragma unroll
        for (int r = 0; r < 16; ++r) x[r] = 0.f;
#pragma unroll
        for (int ks = 0; ks < 8; ++ks) {
            const s16x8 af = *(const LAS s16x8*)(Kt + (32 * si + l31) * QT_LD + 16 * ks + 8 * hi);
            const s16x8 bf = *(const LAS s16x8*)(Qt + (32 * ti + l31) * QT_LD + 16 * ks + 8 * hi);
            x = __builtin_amdgcn_mfma_f32_32x32x16_bf16(af, bf, x, 0, 0, 0);
        }
        bf16_t* pb = (bf16_t*)(p.ws + WS_WB + WB_PBUF) + (size_t)task * 4096 + (32 * ti + l31) * 64 + 32 * si + 4 * hi;
#pragma unroll
        for (int g = 0; g < 4; ++g) {
            float v4[4];
#pragma unroll
            for (int e = 0; e < 4; ++e) { const int sl = 8 * g + 4 * hi + e; v4[e] = (ti == si && sl > l31) ? 0.f : x[4 * g + e]; }
            *(u2*)(pb + 8 * g) = (u2){cvtpk(v4[0], v4[1]), cvtpk(v4[2], v4[3])};
        }
    }
}
__device__ __forceinline__ void gla_chain_blk(const P& p, LAS unsigned char* lds, int nh, int tid, int lane, int wave) {
    using namespace gl;
    const int n = nh >> 2, h = nh & 3, l31 = lane & 31, hi = lane >> 5;
    const bf16_t* QK = (const bf16_t*)(p.ws + WS_S0); const bf16_t* V = (const bf16_t*)(p.ws + WS_S1); bf16_t* RY = (bf16_t*)(p.ws + WS_S2);
    const bf16_t* PB = (const bf16_t*)(p.ws + WS_WB + WB_PBUF) + (size_t)nh * 32 * 4096; const float* DC = (const float*)(p.ws + WS_WB + WB_DEC) + (size_t)nh * 32 * 128;
    constexpr int YW_LD = 40;
    LAS bf16_t* Yw = (LAS bf16_t*)(lds + O_OFF) + wave * (64 * YW_LD);
    LAS float* ssqp = (LAS float*)(lds + G_OFF + 1024);
    LAS float* gl_ = (LAS float*)(lds + G_OFF);
    if (tid < 256) gl_[tid] = p.g_gla[h * DV + tid];
    f32x16 S[4];
#pragma unroll
    for (int j = 0; j < 4; ++j)
#pragma unroll
        for (int r = 0; r < 16; ++r) S[j][r] = 0.f;
    u4 rq[2], rk[2], rp; f4 rd; s16x8 vt[4];
    const int dvg = 32 * wave + l31;
    auto issue_ops = [&](int c) {
        const size_t m0 = (size_t)n * T + 64 * c;
#pragma unroll
        for (int i = 0; i < 2; ++i) { const int pc = tid + 512 * i;
            rq[i] = *(const u4*)(QK + (m0 + (pc >> 4)) * D + h * DK + (pc & 15) * 8);
            const int kk = pc >> 3; rk[i] = *(const u4*)(QK + (m0 + (kk >> 1)) * D + 512 + h * DK + (kk & 1) * 64 + (pc & 7) * 8); }
        rp = *(const u4*)(PB + (size_t)c * 4096 + tid * 8);
        if (tid < 32) rd = *(const f4*)(DC + c * 128 + 4 * tid);
    };
    auto issue_vt = [&](int c) {
        const size_t m0 = (size_t)n * T + 64 * c;
#pragma unroll
        for (int ks = 0; ks < 4; ++ks) vt[ks] = *(const s16x8*)(V + (m0 + (dvg >> 2)) * D + h * DV + (dvg & 3) * 64 + 16 * ks + 8 * hi);
    };
    auto commit = [&](int b) {
        LAS unsigned char* bb = lds + b * BUFSZ;
#pragma unroll
        for (int i = 0; i < 2; ++i) { const int pc = tid + 512 * i;
            *(LAS u4*)(bb + B_QT + ((pc >> 4) * QT_LD + (pc & 15) * 8) * 2) = rq[i];
            *(LAS u4*)(bb + B_KH + ((pc >> 3) * KH_LD + (pc & 7) * 8) * 2) = rk[i]; }
        *(LAS u4*)(bb + B_P + ((tid >> 3) * P_LD + (tid & 7) * 8) * 2) = rp;
        if (tid < 32) *(LAS f4*)(bb + B_DEC + 16 * tid) = rd;
    };
    issue_ops(0); commit(0); issue_ops(1); issue_vt(0);
    __syncthreads();
    for (int c = 0; c < T / 64; ++c) {
        const size_t m0 = (size_t)n * T + 64 * c;
        LAS unsigned char* bb = lds + (c & 1) * BUFSZ;
        const LAS bf16_t* Qt = (const LAS bf16_t*)(bb + B_QT); const LAS bf16_t* Kh = (const LAS bf16_t*)(bb + B_KH); const LAS bf16_t* Pm = (const LAS bf16_t*)(bb + B_P);
        const LAS float* dec = (const LAS float*)(bb + B_DEC);
        bf16_t* ybase = RY + m0 * D + h * DV + 32 * wave;
        u4 rr[4];
#pragma unroll
        for (int i = 0; i < 4; ++i) { const int q = lane + 64 * i; rr[i] = *(const u4*)(ybase + (size_t)(q >> 2) * D + 8 * (q & 3)); }
        f32x16 o0, o1;
#pragma unroll
        for (int r = 0; r < 16; ++r) { o0[r] = 0.f; o1[r] = 0.f; }
#pragma unroll
        for (int ks = 0; ks < 2; ++ks) o0 = __builtin_amdgcn_mfma_f32_32x32x16_bf16(vt[ks], *(const LAS s16x8*)(Pm + l31 * P_LD + 16 * ks + 8 * hi), o0, 0, 0, 0);
#pragma unroll
        for (int ks = 0; ks < 4; ++ks) o1 = __builtin_amdgcn_mfma_f32_32x32x16_bf16(vt[ks], *(const LAS s16x8*)(Pm + (32 + l31) * P_LD + 16 * ks + 8 * hi), o1, 0, 0, 0);
#pragma unroll
        for (int j = 0; j < 4; ++j)
#pragma unroll
            for (int s2 = 0; s2 < 2; ++s2) {
                union { unsigned u[4]; s16x8 v; } sfr;
#pragma unroll
                for (int e = 0; e < 4; ++e) sfr.u[e] = cvtpk(S[j][8 * s2 + 2 * e], S[j][8 * s2 + 2 * e + 1]);
                const int kb = 32 * j + 16 * s2 + 4 * hi;
                union { s16x4 h2[2]; s16x8 v; } q0, q1;
                q0.h2[0] = *(const LAS s16x4*)(Qt + l31 * QT_LD + kb); q0.h2[1] = *(const LAS s16x4*)(Qt + l31 * QT_LD + kb + 8);
                q1.h2[0] = *(const LAS s16x4*)(Qt + (32 + l31) * QT_LD + kb); q1.h2[1] = *(const LAS s16x4*)(Qt + (32 + l31) * QT_LD + kb + 8);
                o0 = __builtin_amdgcn_mfma_f32_32x32x16_bf16(sfr.v, q0.v, o0, 0, 0, 0);
                o1 = __builtin_amdgcn_mfma_f32_32x32x16_bf16(sfr.v, q1.v, o1, 0, 0, 0);
            }
        __builtin_amdgcn_sched_barrier(0);
#pragma unroll
        for (int j = 0; j < 4; ++j) {
            if (j == 2) __builtin_amdgcn_sched_barrier(0);
#pragma unroll
            for (int g = 0; g < 4; ++g) { const f4 d4 = *(const LAS f4*)(dec + 32 * j + 8 * g + 4 * hi);
                S[j][4 * g] *= d4.x; S[j][4 * g + 1] *= d4.y; S[j][4 * g + 2] *= d4.z; S[j][4 * g + 3] *= d4.w; }
#pragma unroll
            for (int ks = 0; ks < 4; ++ks) S[j] = __builtin_amdgcn_mfma_f32_32x32x16_bf16(*(const LAS s16x8*)(Kh + (32 * j + l31) * KH_LD + 16 * ks + 8 * hi), vt[ks], S[j], 0, 0, 0);
        }
        __builtin_amdgcn_sched_barrier(0);
        if (c + 1 < T / 64) issue_vt(c + 1);
        float s0 = 0.f, s1 = 0.f;
#pragma unroll
        for (int r = 0; r < 16; ++r) { s0 += o0[r] * o0[r]; s1 += o1[r] * o1[r]; }
        s0 += __shfl_xor(s0, 32); s1 += __shfl_xor(s1, 32);
        LAS float* sq = ssqp + (c & 1) * 512;
        if (hi == 0) { sq[wave * 64 + l31] = s0; sq[wave * 64 + 32 + l31] = s1; }
        if (c + 1 < T / 64) { commit((c + 1) & 1); if (c + 2 < T / 64) issue_ops(c + 2); }
        __syncthreads();
        float t0 = 0.f, t1 = 0.f;
#pragma unroll
        for (int w8 = 0; w8 < 8; ++w8) { t0 += sq[w8 * 64 + l31]; t1 += sq[w8 * 64 + 32 + l31]; }
        const float rs0 = rsqrtf(t0 * (1.f / DV) + EPS), rs1 = rsqrtf(t1 * (1.f / DV) + EPS);
#pragma unroll
        for (int g = 0; g < 4; ++g) {
            const f4 gv = *(const LAS f4*)(gl_ + 32 * wave + 8 * g + 4 * hi);
            *(LAS u2*)(Yw + l31 * YW_LD + 8 * g + 4 * hi) = (u2){cvtpk(o0[4 * g] * rs0 * gv.x, o0[4 * g + 1] * rs0 * gv.y), cvtpk(o0[4 * g + 2] * rs0 * gv.z, o0[4 * g + 3] * rs0 * gv.w)};
            *(LAS u2*)(Yw + (32 + l31) * YW_LD + 8 * g + 4 * hi) = (u2){cvtpk(o1[4 * g] * rs1 * gv.x, o1[4 * g + 1] * rs1 * gv.y), cvtpk(o1[4 * g + 2] * rs1 * gv.z, o1[4 * g + 3] * rs1 * gv.w)};
        }
        asm volatile("s_waitcnt lgkmcnt(0)" ::: "memory");
#pragma unroll
        for (int i = 0; i < 4; ++i) {
            const int q = lane + 64 * i;
            const u4 yv = *(const LAS u4*)(Yw + (q >> 2) * YW_LD + 8 * (q & 3));
            u4 yo;
#pragma unroll
            for (int e = 0; e < 4; ++e) yo[e] = cvtpk(__uint_as_float(yv[e] << 16) * __uint_as_float(rr[i][e] << 16), __uint_as_float(yv[e] & 0xffff0000u) * __uint_as_float(rr[i][e] & 0xffff0000u));
            *(u4*)(ybase + (size_t)(q >> 2) * D + 8 * (q & 3)) = yo;
        }
        asm volatile("s_waitcnt lgkmcnt(0)" ::: "memory");
    }
    float* gsout = p.out + OUT_GLA_P + (size_t)nh * DK * DV;
#pragma unroll
    for (int j = 0; j < 4; ++j)
#pragma unroll
        for (int r = 0; r < 16; ++r) gsout[(size_t)(32 * j + (r & 3) + 8 * (r >> 2) + 4 * hi) * DV + dvg] = S[j][r];
    __syncthreads();
}

#define XB_XCNT(j)  (512  + 64 * (j))
#define XB_XSUB(j)  (1536 + 64 * (j))
#define XB_XGEN(j)  (2560 + 64 * (j))
#define XB_TOP      3584
#define XB_TOPGEN   3648
__device__ __forceinline__ unsigned xb_ld(unsigned* p)              { return __hip_atomic_load(p, __ATOMIC_RELAXED, __HIP_MEMORY_SCOPE_AGENT); }
__device__ __forceinline__ unsigned xb_add(unsigned* p, unsigned v) { return __hip_atomic_fetch_add(p, v, __ATOMIC_RELAXED, __HIP_MEMORY_SCOPE_AGENT); }
__device__ __forceinline__ unsigned xb_xcc_id() { return (unsigned)__builtin_amdgcn_s_getreg((3 << 11) | 20) & 0xFu; }
__device__ __forceinline__ void xcd_barrier(unsigned* bar, unsigned x, volatile LAS unsigned* st  ) {
    __syncthreads();
    if (threadIdx.x == 0) {
        __builtin_amdgcn_s_waitcnt(0);
        unsigned nloc = st[0], nx = st[1];
        if (nloc == 0u) {
            const unsigned G = gridDim.x; unsigned sum, cnt, mine, sp = 0u;
            for (;;) {
                sum = 0u; cnt = 0u; mine = 0u;
#pragma unroll
                for (unsigned j = 0; j < 16; ++j) { const unsigned c = xb_ld(&bar[XB_XCNT(j)]); sum += c; cnt += (c > 0u) ? 1u : 0u; mine = (j == x) ? c : mine; }
                if (sum == G || ++sp > (1u << 20)) break;
                __builtin_amdgcn_s_sleep(4);
            }
            nloc = mine > 0u ? mine : 1u; nx = cnt > 0u ? cnt : 1u; st[0] = nloc; st[1] = nx;
        }
        const unsigned old = xb_add(&bar[XB_XSUB(x)], 1u);
        __builtin_amdgcn_fence(__ATOMIC_ACQUIRE, "agent");
        const unsigned gen = old / nloc;
        if (old + 1u == (gen + 1u) * nloc) {
            __builtin_amdgcn_fence(__ATOMIC_RELEASE, "agent");
            asm volatile("s_waitcnt vmcnt(0)" ::: "memory");
            const unsigned og = xb_add(&bar[XB_TOP], 1u);
            const unsigned tg = og / nx;
            if (og + 1u == (tg + 1u) * nx) xb_add(&bar[XB_TOPGEN], 1u);
            else { unsigned sp = 0u; while (xb_ld(&bar[XB_TOPGEN]) == tg && ++sp < (1u << 22)) __builtin_amdgcn_s_sleep(4); }
            asm volatile("s_waitcnt vmcnt(0)" ::: "memory");
        } else {
            unsigned sp = 0u; while (xb_ld(&bar[XB_TOPGEN]) == gen && ++sp < (1u << 20)) __builtin_amdgcn_s_sleep(32);
            asm volatile("s_waitcnt vmcnt(0)" ::: "memory");
        }
    }
    __syncthreads();
}

enum { PH_ADA = 0, PH_NORM0, PH_FFN1_IN, PH_FFN1_OUT, PH_NORM1, PH_MIXA, PH_GLAPREP, PH_GLA, PH_MIXB2, PH_BR, PH_MIXOUT, PH_NORM2, PH_FFN2_IN, PH_FFN2_OUT, PH_NORM3, PH_COUNT };
struct Args { P p; int ph_lo, ph_hi; };
typedef short sm_bf16x8 __attribute__((ext_vector_type(8)));
typedef float sm_f4 __attribute__((ext_vector_type(4)));
typedef unsigned sm_u2 __attribute__((ext_vector_type(2)));
template <int KIND>
__device__ __forceinline__ void sample_store(const P& p, int pn, int cw  , size_t row, const sm_f4 (&v)[2]) {
    using namespace pg8;
    unsigned char* ws = p.ws;
    if (KIND == K_ADA) {
        const int r = (int)row; if (r >= NS + NP) return;
        float* ada = (float*)(ws + WS_ADA) + (size_t)(r < NS ? NP + r : r - NS) * NADA;
#pragma unroll
        for (int bj = 0; bj < 2; ++bj) {
            const int n0 = 256 * pn + 128 * bj + cw, sub = n0 / (3 * D), which = (n0 - sub * 3 * D) >> 10, dcol = n0 & (D - 1);
            const sm_f4 bn = *(const sm_f4*)(p.b_ada + n0);
            sm_f4 mul = (sm_f4){1.f, 1.f, 1.f, 1.f}; float add = 0.f;
            if (which == 1) { mul = *(const sm_f4*)(p.g_pre + sub * D + dcol); add = 1.f; }
            else if (which == 2) mul = *(const sm_f4*)(p.g_post + sub * D + dcol) * (sub == 1 ? 1.0f : 0.5f);
            *(sm_f4*)(ada + n0) = (v[bj] + bn + add) * mul;
        }
        return;
    }
    auto st4 = [](bf16_t* d, const sm_f4 x) { const sm_u2 w = (sm_u2){cvt_pk_bf16(x[0], x[1]), cvt_pk_bf16(x[2], x[3])}; if (KIND == K_PLAIN) st_wt((void*)d, w); else *(sm_u2*)d = w; };
    if (KIND == K_SWIGLU || (KIND == K_MIXB && pn >= 4 && pn < 12)) {
        sm_f4 o;
#pragma unroll
        for (int e = 0; e < 4; ++e) o[e] = (KIND == K_SWIGLU ? e_silu(v[0][e]) : v[0][e]) * v[1][e];
        st4((KIND == K_SWIGLU) ? (bf16_t*)(ws + WS_HID) + row * FF + 128 * pn + cw : (bf16_t*)(ws + WS_S4) + row * D + 128 * (pn - 4) + cw, o);
        return;
    }
#pragma unroll
    for (int bj = 0; bj < 2; ++bj) {
        sm_f4 x = v[bj]; bf16_t* d;
        if (KIND == K_MIXA) {
            d = (bf16_t*)(ws + WS_S0 + (size_t)(pn >> 2) * SLAB) + row * D + 256 * (pn & 3) + 128 * bj + cw;
            if (pn < 2) x = x * 0.08838834764831845f;
            else if (pn >= 8) {
#pragma unroll
                for (int e = 0; e < 4; ++e) x[e] = e_silu(x[e]); }
        } else if (KIND == K_MIXB) {
            if (pn < 4) d = (bf16_t*)(ws + WS_S3) + row * D + 256 * pn + 128 * bj + cw;
            else { d = (bf16_t*)(ws + (pn < 16 ? WS_S0 : WS_S1)) + row * D + 256 * ((pn - 12) & 3) + 128 * bj + cw;
#pragma unroll
                for (int e = 0; e < 4; ++e) x[e] = e_sigmoid(x[e]); }
        } else if (KIND == K_PLAIN) {
            d = (bf16_t*)(ws + WS_Y) + row * D + 256 * pn + 128 * bj + cw;
        } else {
            const size_t off = row * D + 256 * pn + 128 * bj + cw;
            bf16_t* pa = (bf16_t*)(ws + WS_S0) + off; bf16_t* pb = (bf16_t*)(ws + WS_S1) + off;
            const sm_u2 ga = *(const sm_u2*)pa;
            if (KIND == K_GATE0) { x[0] *= bfl(ga.x); x[1] *= bfh(ga.x); x[2] *= bfl(ga.y); x[3] *= bfh(ga.y); d = pa; }
            else { const sm_u2 gb = *(const sm_u2*)pb;
                x[0] = bfl(ga.x) + bfl(gb.x) * x[0]; x[1] = bfh(ga.x) + bfh(gb.x) * x[1]; x[2] = bfl(ga.y) + bfl(gb.y) * x[2]; x[3] = bfh(ga.y) + bfh(gb.y) * x[3]; d = pb; }
        }
        st4(d, x);
    }
}
template <int NS>
__device__ __forceinline__ void sample_batch(const bf16_t* ap, const bf16_t* bp, int K, int k0, sm_f4 (&acc)[4][2]) {
    sm_bf16x8 af[4][NS], bf[2][NS];
#pragma unroll
    for (int m = 0; m < 4; ++m)
#pragma unroll
        for (int s = 0; s < NS; ++s) af[m][s] = *(const sm_bf16x8*)(ap + (size_t)(16 * m) * K + k0 + 32 * s);
#pragma unroll
    for (int bj = 0; bj < 2; ++bj)
#pragma unroll
        for (int s = 0; s < NS; ++s) bf[bj][s] = *(const sm_bf16x8*)(bp + (size_t)(128 * bj) * K + k0 + 32 * s);
    __builtin_amdgcn_sched_barrier(0);
#pragma unroll
    for (int s = 0; s < NS; ++s)
#pragma unroll
        for (int m = 0; m < 4; ++m)
#pragma unroll
            for (int bj = 0; bj < 2; ++bj) acc[m][bj] = __builtin_amdgcn_mfma_f32_16x16x32_bf16(bf[bj][s], af[m][s], acc[m][bj], 0, 0, 0);
}
template <int NS>
__device__ __forceinline__ void sample_batch_f32w(const float* const (&crow)[4], const float* wp  , int ldw, int k0, sm_f4 (&acc)[4][2]) {
    sm_f4 cv[4][NS][2]; float wv[2][NS][8];
#pragma unroll
    for (int m = 0; m < 4; ++m)
#pragma unroll
        for (int s = 0; s < NS; ++s)
#pragma unroll
            for (int h2 = 0; h2 < 2; ++h2) cv[m][s][h2] = crow[m] ? *(const sm_f4*)(crow[m] + k0 + 32 * s + 4 * h2) : (sm_f4){0.f, 0.f, 0.f, 0.f};
#pragma unroll
    for (int bj = 0; bj < 2; ++bj)
#pragma unroll
        for (int s = 0; s < NS; ++s)
#pragma unroll
            for (int j = 0; j < 8; ++j) wv[bj][s][j] = __builtin_nontemporal_load(wp + (size_t)(k0 + 32 * s + j) * ldw + 128 * bj);
    __builtin_amdgcn_sched_barrier(0);
#pragma unroll
    for (int s = 0; s < NS; ++s) {
        sm_bf16x8 af[4];
#pragma unroll
        for (int m = 0; m < 4; ++m) { union { unsigned u[4]; sm_bf16x8 v; } t;
#pragma unroll
            for (int e = 0; e < 2; ++e) { t.u[e] = pg8::cvt_pk_bf16(pg8::e_silu(cv[m][s][0][2 * e]), pg8::e_silu(cv[m][s][0][2 * e + 1])); t.u[2 + e] = pg8::cvt_pk_bf16(pg8::e_silu(cv[m][s][1][2 * e]), pg8::e_silu(cv[m][s][1][2 * e + 1])); }
            af[m] = t.v; }
#pragma unroll
        for (int bj = 0; bj < 2; ++bj) {
            union { unsigned u[4]; sm_bf16x8 v; } bf;
#pragma unroll
            for (int e = 0; e < 4; ++e) bf.u[e] = pg8::cvt_pk_bf16(wv[bj][s][2 * e], wv[bj][s][2 * e + 1]);
#pragma unroll
            for (int m = 0; m < 4; ++m) acc[m][bj] = __builtin_amdgcn_mfma_f32_16x16x32_bf16(bf.v, af[m], acc[m][bj], 0, 0, 0);
        }
    }
}
template <int KIND, int K>
__device__ __forceinline__ int sample_tasks(const P& p, LAS unsigned char* lds, const bf16_t* A  , const bf16_t* Bt, int N, int wave, int lane, int pn_off, int nrh, size_t row_base, bool from_last, const float* Wf32 = nullptr, int ldw = 0, int nlast = 0  ) {
    constexpr int KS = K / 256;
    static_assert(KS == 4 || KS == 11, "sample_tasks: K is 1024 or 2816");
    const int fr = lane & 15, fq = lane >> 4, ntask = (N >> 8) * 8 * nrh, G = (int)gridDim.x;
    LAS float* part = (LAS float*)lds; int ndone = 0;
    const bool xcd_map = (KIND == pg8::K_ADA) && (G % 8 == 0);
    const int xg = (int)blockIdx.x & 7, yg = (int)blockIdx.x >> 3, ngrp = (N >> 8) * 8, per_x = ((ngrp + 7) >> 3) * nrh;
    const int nl = (from_last && nlast > 0) ? nlast : G;
    if (from_last && G - 1 - (int)blockIdx.x >= nl) return 0;
    for (int t = xcd_map ? yg : (from_last ? G - 1 - (int)blockIdx.x : (int)blockIdx.x); t < (xcd_map ? per_x : ntask); t += (xcd_map ? (G >> 3) : nl)) {
        int rh, ti;
        if (xcd_map) { rh = t % nrh; ti = (t / nrh) * 8 + xg; if (ti >= ngrp) continue; } else { rh = t % nrh; ti = t / nrh; }
        const int pn = ti >> 3, i8 = ti & 7;
        const bf16_t* ap = A + (size_t)(64 * rh + fr) * K + 8 * fq + wave * (KS * 32);
        const bf16_t* bp = Bt + (size_t)(256 * pn + 16 * i8 + fr) * K + 8 * fq + wave * (KS * 32);
        sm_f4 acc[4][2];
#pragma unroll
        for (int m = 0; m < 4; ++m)
#pragma unroll
            for (int bj = 0; bj < 2; ++bj) acc[m][bj] = (sm_f4){0.f, 0.f, 0.f, 0.f};
        if (KIND == pg8::K_ADA) {
            const float* wp = Wf32 + (size_t)(wave * (KS * 32) + 8 * fq) * ldw + 256 * pn + 16 * i8 + fr;
            const float* crow[4];
#pragma unroll
            for (int m = 0; m < 4; ++m) { const int r = 64 * rh + 16 * m + fr;
                crow[m] = r < NS ? p.c_sample + (size_t)r * D + wave * (KS * 32) + 8 * fq : r < NS + NP ? p.c_prompt + (size_t)(r - NS) * D + wave * (KS * 32) + 8 * fq : nullptr; }
            sample_batch_f32w<2>(crow, wp, ldw, 0, acc); sample_batch_f32w<2>(crow, wp, ldw, 64, acc);
        } else if (KS == 4) sample_batch<4>(ap, bp, K, 0, acc);
        else { sample_batch<6>(ap, bp, K, 0, acc); sample_batch<5>(ap, bp, K, 192, acc); }
#pragma unroll
        for (int m = 0; m < 4; ++m)
#pragma unroll
            for (int bj = 0; bj < 2; ++bj)
#pragma unroll
                for (int e = 0; e < 4; ++e) part[((((wave * 4 + m) * 2 + bj) * 4 + e) << 6) + lane] = acc[m][bj][e];
        __syncthreads();
        if (wave < 4) {
            sm_f4 v[2];
#pragma unroll
            for (int bj = 0; bj < 2; ++bj)
#pragma unroll
                for (int e = 0; e < 4; ++e) {
                    float s = 0.f;
#pragma unroll
                    for (int q = 0; q < 8; ++q) s += part[((((q * 4 + wave) * 2 + bj) * 4 + e) << 6) + lane];
                    v[bj][e] = s;
                }
            sample_store<KIND>(p, pn + pn_off, 16 * i8 + 4 * fq, row_base + 64 * rh + 16 * wave + fr, v);
        }
        __syncthreads(); ++ndone;
    }
    return ndone;
}
template <int KIND, int K>
__device__ __forceinline__ void run_gemm(const Args& a, LAS unsigned char* lds, const bf16_t* A, const bf16_t* Bt, int N, int b0 = 0, int pn_off = 0, int cgroup = -1, bool with_sample = true) {
    const int Gs = (int)gridDim.x - b0, cs = (int)blockIdx.x - b0;
    pg8::Gemm g{A, Bt, MP, N, K}; pg8::StaticOrder S; S.init(MP, N, Gs, cs);
    pg8::EpiGen<KIND> E{a.p.ws, pn_off};
    pg8::gemm_phase<pg8::EpiGen<KIND>, pg8::StaticOrder, true, true>(lds, g, S, E);
    const int wave = __builtin_amdgcn_readfirstlane(threadIdx.x >> 6), lane = threadIdx.x & 63;
    if (with_sample) { const int rem_ = ((MP >> 8) * (N >> 8)) % Gs;
        sample_tasks<KIND, K>(a.p, lds, A + (size_t)MP * K, Bt, N, wave, lane, pn_off, 2, (size_t)MP, true, nullptr, 0, rem_ ? Gs - rem_ : 0); }
    if (cgroup >= 0) {
        const int rem = ((MP >> 8) * (N >> 8)) % Gs;
        if (rem != 0 && cs >= rem) { __syncthreads(); phase_convert(a.p, lds, (cs - rem) * NWAVES + wave, (Gs - rem) * NWAVES, wave, lane, cgroup); }
    }
}
template <int K>
__device__ __forceinline__ void deferred_sample_tasks(const Args& a, LAS unsigned char* lds, const bf16_t* A, const bf16_t* Bt, unsigned* cnt, int wave, int lane) {
    const int nd = sample_tasks<pg8::K_PLAIN, K>(a.p, lds, A + (size_t)MP * K, Bt, D, wave, lane, 0, 2, (size_t)MP, true);
    if (nd > 0) {
        asm volatile("s_waitcnt vmcnt(0)" ::: "memory");
        __syncthreads();
        if (threadIdx.x == 0) __hip_atomic_fetch_add(cnt, (unsigned)nd, __ATOMIC_RELAXED, __HIP_MEMORY_SCOPE_AGENT);
    }
}
__global__ void __launch_bounds__(NWAVES * 64, 2) mega(Args a) {
    extern __shared__ __attribute__((aligned(16))) unsigned char lds_raw[];
    LAS unsigned char* lds = (LAS unsigned char*)lds_raw;
    cg::grid_group grid = cg::this_grid();
    const int tid = threadIdx.x, lane = tid & 63, wave = __builtin_amdgcn_readfirstlane(tid >> 6);
    const int gw = blockIdx.x * NWAVES + wave, ngw = gridDim.x * NWAVES;
    const int gtid = blockIdx.x * (NWAVES * 64) + tid, ngt = gridDim.x * NWAVES * 64;
    unsigned char* ws = a.p.ws; unsigned char* wb = ws + WS_WB;
    const bf16_t *XN = (const bf16_t*)(ws + WS_XN), *HID = (const bf16_t*)(ws + WS_HID), *S1 = (const bf16_t*)(ws + WS_S1), *S2 = (const bf16_t*)(ws + WS_S2), *S3 = (const bf16_t*)(ws + WS_S3);
#define IN(k) (a.ph_lo <= (k) && (k) < a.ph_hi)
#define SEAM(k) do { if (IN(k) && IN((k) + 1)) { asm volatile("s_waitcnt vmcnt(0)" ::: "memory"); xcd_barrier(bar, xcc, xb_st); } } while (0)
    unsigned* bar = (unsigned*)(a.p.ws + WS_CTL);
    const unsigned xcc = xb_xcc_id(); volatile LAS unsigned* xb_st = (volatile LAS unsigned*)(lds + 147424);
    if (tid == 0) { xb_st[0] = 0u; xb_st[1] = 0u; }
    if (blockIdx.x == 0 && tid < 64) {
        if (tid < 16) { __hip_atomic_store(bar + XB_XCNT(tid), 0u, __ATOMIC_RELAXED, __HIP_MEMORY_SCOPE_AGENT); __hip_atomic_store(bar + XB_XSUB(tid), 0u, __ATOMIC_RELAXED, __HIP_MEMORY_SCOPE_AGENT);
            __hip_atomic_store(bar + XB_XGEN(tid), 0u, __ATOMIC_RELAXED, __HIP_MEMORY_SCOPE_AGENT); }
        else if (tid == 16) { __hip_atomic_store(bar + XB_TOP, 0u, __ATOMIC_RELAXED, __HIP_MEMORY_SCOPE_AGENT); __hip_atomic_store(bar + XB_TOPGEN, 0u, __ATOMIC_RELAXED, __HIP_MEMORY_SCOPE_AGENT); }
        else if (tid >= 18 && tid < 21) __hip_atomic_store(bar + 64 * (tid - 16), 0u, __ATOMIC_RELAXED, __HIP_MEMORY_SCOPE_AGENT);
    }
    grid.sync();
    if (tid == 0) (void)xb_add(&bar[XB_XCNT(xcc)], 1u);
    if (IN(PH_ADA)) {
        sample_tasks<pg8::K_ADA, D>(a.p, lds, nullptr, nullptr, NADA, wave, lane, 0, 3, 0, false, a.p.w_ada, NADA);
        __syncthreads();
        phase_convert(a.p, lds, gw, ngw, wave, lane, 0);
    }
    SEAM(PH_ADA);
    if (IN(PH_NORM0)) norm_phase<0>(a.p, wave, lane, nullptr);
    SEAM(PH_NORM0);
    if (IN(PH_FFN1_IN)) run_gemm<pg8::K_SWIGLU, D>(a, lds, XN, (const bf16_t*)(wb + WB_W1IN), 2 * FF, 0, 0, 1);
    SEAM(PH_FFN1_IN);
    if (IN(PH_FFN1_OUT)) run_gemm<pg8::K_PLAIN, FF>(a, lds, HID, (const bf16_t*)(wb + WB_W1OUT), D, 0, 0, -1, false);
    SEAM(PH_FFN1_OUT);
    if (IN(PH_NORM1)) {
        deferred_sample_tasks<FF>(a, lds, HID, (const bf16_t*)(wb + WB_W1OUT), bar + 128, wave, lane);
        LAS float* wzt = (LAS float*)lds;
        __syncthreads();
        for (int i = tid; i < D * 16; i += NWAVES * 64) { const int c = i >> 4, q = i & 15; wzt[q * D + c] = a.p.w_mix_in[(size_t)c * MIXW + O_Z + q]; }
        __syncthreads();
        norm_phase<1>(a.p, wave, lane, wzt, bar + 128, 64u, 5);
        __syncthreads();
    }
    SEAM(PH_NORM1);
    if (IN(PH_MIXA)) run_gemm<pg8::K_MIXA, D>(a, lds, XN, (const bf16_t*)(wb + WB_MIXA), 3072, 0, 0, -1, false);
    SEAM(PH_MIXA);
    if (IN(PH_GLAPREP)) {
        sample_tasks<pg8::K_MIXA, D>(a.p, lds, XN + (size_t)MP * D, (const bf16_t*)(wb + WB_MIXA), 3072, wave, lane, 0, 2, (size_t)MP, true);
        __syncthreads();
        for (int task = (int)blockIdx.x; task < NP * NH * 32; task += (int)gridDim.x) gla_prep_task(a.p, lds, task, tid, lane, wave);
        __syncthreads();
    }
    SEAM(PH_GLAPREP);
    if (IN(PH_GLA)) {
        __syncthreads();
        if (blockIdx.x < NP * NH) gla_chain_blk(a.p, lds, (int)blockIdx.x, tid, lane, wave);
        else {
            run_gemm<pg8::K_MIXB, D>(a, lds, XN, (const bf16_t*)(wb + WB_MIXB), 3072, NP * NH, 0, 2);
            for (int task = (int)blockIdx.x - NP * NH; task < NS * NH; task += (int)gridDim.x - NP * NH) { __syncthreads(); gla_sample_naive_blk(a.p, (LAS float*)lds, task, tid); }
        }
    }
    SEAM(PH_GLA);
    if (IN(PH_MIXB2)) {
        constexpr int CH = MT * (D / 8) / 2;
        const int half_gtid = (int)(blockIdx.x >> 1) * (NWAVES * 64) + tid, half_ngt = (int)(gridDim.x >> 1) * NWAVES * 64;
        if (blockIdx.x & 1) phase_conv(a.p, half_gtid, half_ngt, 0, CH);
        run_gemm<pg8::K_MIXB, D>(a, lds, XN, (const bf16_t*)(wb + WB_MIXB) + (size_t)3072 * D, 2048, 0, 12);
        if (!(blockIdx.x & 1)) phase_conv(a.p, half_gtid, half_ngt, CH, MT * (D / 8));
    }
    SEAM(PH_MIXB2);
    if (IN(PH_BR)) {
        run_gemm<pg8::K_GATE0, D>(a, lds, S2, (const bf16_t*)(wb + WB_BR), D);
        run_gemm<pg8::K_GATE1, D>(a, lds, S3, (const bf16_t*)(wb + WB_BR) + (size_t)D * D, D);
    }
    SEAM(PH_BR);
    if (IN(PH_MIXOUT)) run_gemm<pg8::K_PLAIN, D>(a, lds, S1, (const bf16_t*)(wb + WB_MO), D, 0, 0, -1, false);
    SEAM(PH_MIXOUT);
    if (IN(PH_NORM2)) { deferred_sample_tasks<D>(a, lds, S1, (const bf16_t*)(wb + WB_MO), bar + 192, wave, lane); norm_phase<2>(a.p, wave, lane, nullptr, bar + 192, 64u, 3); }
    SEAM(PH_NORM2);
    if (IN(PH_FFN2_IN)) run_gemm<pg8::K_SWIGLU, D>(a, lds, XN, (const bf16_t*)(wb + WB_W2IN), 2 * FF);
    SEAM(PH_FFN2_IN);
    if (IN(PH_FFN2_OUT)) run_gemm<pg8::K_PLAIN, FF>(a, lds, HID, (const bf16_t*)(wb + WB_W2OUT), D, 0, 0, -1, false);
    SEAM(PH_FFN2_OUT);
    if (IN(PH_NORM3)) { deferred_sample_tasks<FF>(a, lds, HID, (const bf16_t*)(wb + WB_W2OUT), bar + 256, wave, lane); norm_phase<3>(a.p, wave, lane, nullptr, bar + 256, 64u, 10); }
#undef IN
#undef SEAM
}

#ifndef MK_PER_PHASE
#define MK_PER_PHASE 0
#endif
extern "C" void kernel_launch(void* const* d_in, const int* in_sizes, int n_in, void* d_out, int out_size, void* d_ws, size_t ws_size, hipStream_t stream) {
    if (n_in != 21 || ws_size < WS_END || out_size != (int)(OUT_CONV_S + (size_t)NS * 2 * D)) {
        fprintf(stderr, "kernel_launch: unexpected sizes n_in=%d ws=%zu need=%zu out=%d\n", n_in, ws_size, (size_t)WS_END, out_size);
        return;
    }
    static int grid = 0;
    if (grid == 0) {
        int dev = 0, cus = 0, per_cu = 0;
        hipGetDevice(&dev); hipDeviceGetAttribute(&cus, hipDeviceAttributeMultiprocessorCount, dev);
        hipFuncSetAttribute((const void*)mega, hipFuncAttributeMaxDynamicSharedMemorySize, LDS_BYTES);
        hipOccupancyMaxActiveBlocksPerMultiprocessor(&per_cu, (const void*)mega, NWAVES * 64, LDS_BYTES);
        if (per_cu < 1) { fprintf(stderr, "kernel_launch: occupancy query says %d blocks per CU\n", per_cu); per_cu = 1; }
        grid = (cus > 0 ? cus : 256);
        (void)hipGetLastError();
    }
    Args a{};
    const float** f = (const float**)&a.p;
    for (int i = 0; i < 21; ++i) f[i] = (const float*)d_in[i];
    a.p.out = (float*)d_out; a.p.ws = (unsigned char*)d_ws;
#if MK_PER_PHASE
    for (int k = 0; k < PH_COUNT; ++k) { a.ph_lo = k; a.ph_hi = k + 1; hipLaunchKernelGGL(mega, dim3(grid), dim3(NWAVES * 64), LDS_BYTES, stream, a); }
#else
    a.ph_lo = 0; a.ph_hi = PH_COUNT;
    void* args[] = {&a};
    hipError_t e = hipLaunchCooperativeKernel((const void*)mega, dim3(grid), dim3(NWAVES * 64), args, LDS_BYTES, stream);
    if (e != hipSuccess) fprintf(stderr, "kernel_launch: cooperative launch failed: %s (grid %d)\n", hipGetErrorString(e), grid);
#endif
}
```

```cpp
#include <hip/hip_runtime.h>
#include <cstdint>
#include <hip/hip_cooperative_groups.h>
#include <cstdio>
namespace cg = cooperative_groups;
#include <cstdlib>

typedef unsigned short bf16_t;
constexpr int D = 1024, NP = 8, T = 2048, NS = 128, MP = NP * T, MT = MP + NS, R = 16640;
constexpr int FF = 2816, MIXW = 8208, NADA = 9216;
constexpr int NH = 4, DK = 128, DV = 256;
constexpr float EPS = 1e-6f;
constexpr int O_Q = 0, O_K = 512, O_V = 1024, O_R = 2048, O_Z = 3072, O_B = 3088, O_C = 4112, O_H = 5136, O_GA = 6160, O_GB = 7184;
constexpr size_t OUT_Y = 0, OUT_GLA_P = (size_t)MT * D, OUT_CONV_P = OUT_GLA_P + (size_t)NP * NH * DK * DV,
                 OUT_GLA_S = OUT_CONV_P + (size_t)NP * 2 * D, OUT_CONV_S = OUT_GLA_S + (size_t)NS * NH * DK * DV;
constexpr size_t MiB = 1u << 20;
constexpr size_t WS_CTL = 0, WS_ADA = 1 * MiB, WS_Z = 6 * MiB, WS_WB = 8 * MiB;
constexpr size_t SLAB = (size_t)R * D * 2;
constexpr size_t WS_XN = WS_WB + 73 * MiB, WS_S0 = WS_XN + SLAB, WS_S1 = WS_S0 + SLAB, WS_S2 = WS_S1 + SLAB, WS_S3 = WS_S2 + SLAB, WS_S4 = WS_S3 + SLAB,
                 WS_END = WS_S4 + SLAB;
constexpr size_t WS_HID = WS_S0, WS_Y = WS_S4;

__device__ __forceinline__ float bf2f(bf16_t b) { return __uint_as_float((unsigned)b << 16); }
__device__ __forceinline__ bf16_t f2bf(float f) { unsigned u = __float_as_uint(f); return (bf16_t)((u + 0x7fffu + ((u >> 16) & 1u)) >> 16); }
__device__ __forceinline__ float silu_f(float x) { return x / (1.f + __expf(-x)); }
__device__ __forceinline__ float sigmoid_f(float x) { return 1.f / (1.f + __expf(-x)); }
__device__ __forceinline__ float logsig_f(float x) { return fminf(x, 0.f) - log1pf(expf(-fabsf(x))); }
__device__ __forceinline__ float wave_sum(float v) {
#pragma unroll
    for (int o = 1; o < 64; o <<= 1) v += __shfl_xor(v, o);
    return v;
}


typedef float wt_f4 __attribute__((ext_vector_type(4)));
typedef unsigned wt_u4 __attribute__((ext_vector_type(4)));
typedef unsigned wt_u2 __attribute__((ext_vector_type(2)));
__device__ __forceinline__ void st_wt(float* p, wt_f4 v) { asm volatile("global_store_dwordx4 %0, %1, off sc1\n\ts_nop 1" :: "v"(p), "v"(v) : "memory"); }
__device__ __forceinline__ void st_wt(void* p, wt_u4 v) { asm volatile("global_store_dwordx4 %0, %1, off sc1\n\ts_nop 1" :: "v"(p), "v"(v) : "memory"); }
__device__ __forceinline__ void st_wt(void* p, wt_u2 v) { asm volatile("global_store_dwordx2 %0, %1, off sc1\n\ts_nop 1" :: "v"(p), "v"(v) : "memory"); }
struct P {
    const float *x_prompt, *x_sample, *state_gla, *state_conv, *c_prompt, *c_sample, *w_ada, *b_ada, *g_pre, *g_post, *w_ffn1_in, *w_ffn1_out, *w_ffn2_in, *w_ffn2_out,
        *w_mix_in, *w_alpha, *b_alpha, *g_gla, *w_conv, *w_branch, *w_mix_out;
    float* out; unsigned char* ws;
};

constexpr int NWAVES_N = 8;
typedef float nf4 __attribute__((ext_vector_type(4)));
typedef unsigned nu2 __attribute__((ext_vector_type(2)));
struct NormRow { nf4 x[4]; nu2 xb[4]; nu2 y[4]; };
template <int MODE>
__device__ __forceinline__ void norm_load(const P& p, int m, int lane, NormRow& r) {
    if (MODE <= 1) {
        const float* xsrc = m < MP ? p.x_prompt + (size_t)m * D : p.x_sample + (size_t)(m - MP) * D;
#pragma unroll
        for (int j = 0; j < 4; ++j) r.x[j] = __builtin_nontemporal_load((const nf4*)(xsrc + 4 * lane + 256 * j));
    } else {
        const bf16_t* xsrc = (MODE == 2 ? (const bf16_t*)(p.out + OUT_Y) : (const bf16_t*)(p.ws + WS_S3)) + (size_t)m * D;
#pragma unroll
        for (int j = 0; j < 4; ++j) r.xb[j] = __builtin_nontemporal_load((const nu2*)(xsrc + 4 * lane + 256 * j));
    }
    if (MODE >= 1) {
        const bf16_t* y = (const bf16_t*)(p.ws + WS_Y) + (size_t)m * D;
#pragma unroll
        for (int j = 0; j < 4; ++j) r.y[j] = __builtin_nontemporal_load((const nu2*)(y + 4 * lane + 256 * j));
    }
}
template <int MODE>
__device__ __forceinline__ void norm_vecs(const P& p, int ar, int lane, nf4 (&gw)[4], nf4 (&scl)[4], nf4 (&sh)[4]) {
    const float* ada = (const float*)(p.ws + WS_ADA) + (size_t)ar * NADA;
#pragma unroll
    for (int j = 0; j < 4; ++j) {
        if (MODE >= 1) gw[j] = *(const nf4*)(ada + (3 * (MODE - 1) + 2) * D + 4 * lane + 256 * j);
        if (MODE <= 2) { scl[j] = *(const nf4*)(ada + (3 * MODE + 1) * D + 4 * lane + 256 * j); sh[j] = *(const nf4*)(ada + (3 * MODE + 0) * D + 4 * lane + 256 * j); }
    }
}
template <int MODE>
__device__ __forceinline__ void norm_compute(const P& p, int m, int lane, const NormRow& r, const nf4 (&gw)[4], const nf4 (&scl)[4], const nf4 (&sh)[4], const __attribute__((address_space(3))) float* wzt) {
    nf4 xv[4];
#pragma unroll
    for (int j = 0; j < 4; ++j) xv[j] = (MODE <= 1) ? r.x[j] : (nf4){__uint_as_float(r.xb[j].x << 16), __uint_as_float(r.xb[j].x & 0xffff0000u), __uint_as_float(r.xb[j].y << 16), __uint_as_float(r.xb[j].y & 0xffff0000u)};
    if (MODE >= 1) {
        nf4 yv[4]; float ss = 0.f;
#pragma unroll
        for (int j = 0; j < 4; ++j) { yv[j] = (nf4){__uint_as_float(r.y[j].x << 16), __uint_as_float(r.y[j].x & 0xffff0000u), __uint_as_float(r.y[j].y << 16), __uint_as_float(r.y[j].y & 0xffff0000u)};
            ss += (yv[j].x * yv[j].x + yv[j].y * yv[j].y) + (yv[j].z * yv[j].z + yv[j].w * yv[j].w); }
        const float rs = rsqrtf(wave_sum(ss) * (1.f / D) + EPS);
#pragma unroll
        for (int j = 0; j < 4; ++j) { xv[j] += gw[j] * (yv[j] * rs);
            if (MODE == 3) __builtin_nontemporal_store(xv[j], (nf4*)(p.out + OUT_Y + (size_t)m * D + 4 * lane + 256 * j));
            else { nu2 t; t.x = (unsigned)f2bf(xv[j].x) | ((unsigned)f2bf(xv[j].y) << 16); t.y = (unsigned)f2bf(xv[j].z) | ((unsigned)f2bf(xv[j].w) << 16);
                __builtin_nontemporal_store(t, (nu2*)((MODE == 1 ? (bf16_t*)(p.out + OUT_Y) : (bf16_t*)(p.ws + WS_S3)) + (size_t)m * D + 4 * lane + 256 * j)); } }
    }
    if (MODE <= 2) {
        float ss = 0.f;
#pragma unroll
        for (int j = 0; j < 4; ++j) ss += (xv[j].x * xv[j].x + xv[j].y * xv[j].y) + (xv[j].z * xv[j].z + xv[j].w * xv[j].w);
        const float rs = rsqrtf(wave_sum(ss) * (1.f / D) + EPS);
        nf4 hv[4];
        bf16_t* xn = (bf16_t*)(p.ws + WS_XN) + (size_t)m * D;
#pragma unroll
        for (int j = 0; j < 4; ++j) {
            hv[j] = xv[j] * rs * scl[j] + sh[j];
            nu2 t; t.x = (unsigned)f2bf(hv[j].x) | ((unsigned)f2bf(hv[j].y) << 16); t.y = (unsigned)f2bf(hv[j].z) | ((unsigned)f2bf(hv[j].w) << 16);
            st_wt((void*)(xn + 4 * lane + 256 * j), t); }
        if (MODE == 1) {
            float zq[16];
#pragma unroll
            for (int q = 0; q < 16; ++q) {
                float s = 0.f;
#pragma unroll
                for (int j = 0; j < 4; ++j) { const nf4 w = *(const __attribute__((address_space(3))) nf4*)(wzt + q * D + 4 * lane + 256 * j); s += (hv[j].x * w.x + hv[j].y * w.y) + (hv[j].z * w.z + hv[j].w * w.w); }
                zq[q] = s;
                if ((q & 3) == 3) __builtin_amdgcn_sched_barrier(0);
            }
            const bool b5 = (lane >> 5) & 1, b4 = (lane >> 4) & 1, b3 = (lane >> 3) & 1, b2 = (lane >> 2) & 1;
#pragma unroll
            for (int i2 = 0; i2 < 8; ++i2) { const float keep = b5 ? zq[i2 + 8] : zq[i2], send = b5 ? zq[i2] : zq[i2 + 8]; zq[i2] = keep + __shfl_xor(send, 32); }
#pragma unroll
            for (int i2 = 0; i2 < 4; ++i2) { const float keep = b4 ? zq[i2 + 4] : zq[i2], send = b4 ? zq[i2] : zq[i2 + 4]; zq[i2] = keep + __shfl_xor(send, 16); }
#pragma unroll
            for (int i2 = 0; i2 < 2; ++i2) { const float keep = b3 ? zq[i2 + 2] : zq[i2], send = b3 ? zq[i2] : zq[i2 + 2]; zq[i2] = keep + __shfl_xor(send, 8); }
            { const float keep = b2 ? zq[1] : zq[0], send = b2 ? zq[0] : zq[1]; zq[0] = keep + __shfl_xor(send, 4); }
            zq[0] += __shfl_xor(zq[0], 2); zq[0] += __shfl_xor(zq[0], 1);
            if ((lane & 3) == 0) ((float*)(p.ws + WS_Z))[(size_t)m * 16 + (int)b2 + 2 * (int)b3 + 4 * (int)b4 + 8 * (int)b5] = zq[0];
        }
    }
}
template <int MODE>
__device__ __forceinline__ void norm_phase(const P& p, int wave, int lane, const __attribute__((address_space(3))) float* wzt, unsigned* wait_cnt = nullptr, unsigned wait_target = 0u, int shift = 0) {
    const int b = (int)blockIdx.x, G = (int)gridDim.x;
    nf4 gw[4], scl[4], sh[4];
    int r0, cnt;
    if (G == 256) { if (b < 192) { cnt = 64 + shift; r0 = b * cnt; } else { cnt = 64 - 3 * shift; r0 = 192 * (64 + shift) + (b - 192) * cnt; } }
    else { const int per = (MP + G - 1) / G; r0 = b * per; cnt = (r0 + per <= MP) ? per : (MP > r0 ? MP - r0 : 0); }
    {
        int cur_ar = -1;
        NormRow cur, nxt;
        int m = r0 + wave;
        if (m < r0 + cnt) norm_load<MODE>(p, m, lane, cur);
#pragma unroll 1
        for (; m < r0 + cnt; m += 8) {
            if (m + 8 < r0 + cnt) norm_load<MODE>(p, m + 8, lane, nxt);
            if ((m >> 11) != cur_ar) { cur_ar = m >> 11; norm_vecs<MODE>(p, cur_ar, lane, gw, scl, sh); }
            norm_compute<MODE>(p, m, lane, cur, gw, scl, sh, wzt);
            cur = nxt;
        }
    }
    for (int s = b * NWAVES_N + wave; s < NS; s += (int)gridDim.x * NWAVES_N) {
        if (wait_cnt) {
            if (lane == 0) while (__hip_atomic_load(wait_cnt, __ATOMIC_RELAXED, __HIP_MEMORY_SCOPE_AGENT) < wait_target) __builtin_amdgcn_s_sleep(16);
            __builtin_amdgcn_fence(__ATOMIC_ACQUIRE, "agent");
            asm volatile("s_waitcnt vmcnt(0)" ::: "memory");
        }
        NormRow cur;
        norm_vecs<MODE>(p, NP + s, lane, gw, scl, sh);
        norm_load<MODE>(p, MP + s, lane, cur);
        norm_compute<MODE>(p, MP + s, lane, cur, gw, scl, sh, wzt);
    }
}

namespace pg8 {
#define PG8_LAS __attribute__((address_space(3)))
typedef unsigned short bf16_t;
typedef short bf16x8 __attribute__((ext_vector_type(8)));
typedef float f32x4 __attribute__((ext_vector_type(4)));
typedef unsigned u32x4 __attribute__((ext_vector_type(4)));
constexpr int BM = 256, BK = 64, HALF = 128, HTB = HALF * BK * 2  , STAGE_BYTES = 8 * HTB, NXCD = 8, WGM = 8;

__host__ __device__ __forceinline__ int lds_byte(int r, int c) { const int st = (r >> 4) * 2 + (c >> 5), rr = r & 15, cc = c & 31, ob = rr * 64 + cc * 2; return st * 1024 + (ob ^ (((ob >> 9) & 1) << 5)); }
__host__ __device__ __forceinline__ void stage_rc(int b, int& R, int& C) { const int st = b / 1024, sb = b % 1024, swz = sb ^ (((sb >> 9) & 1) << 5); R = (st >> 1) * 16 + swz / 64; C = (st & 1) * 32 + (swz % 64) / 2; }
__host__ __device__ __forceinline__ int perm32(int rho) { const int n = rho >> 4, i = rho & 15; return 8 * (i >> 2) + 4 * n + (i & 3); }

struct Unit { int pm, pn; };
struct Gemm { const bf16_t* A; const bf16_t* Bt; int M, N, K; };

struct StaticOrder {
    int nM, nN, nwg, G, c;
    __host__ __device__ void init(int M, int N, int G_, int c_) { nM = M / BM; nN = N / BM; nwg = nM * nN; G = G_; c = c_; }
    __host__ __device__ bool next(int i, Unit& u) const {
        const long L = (long)i * G + c; if (L >= nwg) return false;
        int wgid = (int)L; { const int q = nwg / NXCD, r = nwg % NXCD, xcd = wgid % NXCD, off = wgid / NXCD; wgid = (xcd < r ? xcd * (q + 1) : r * (q + 1) + (xcd - r) * q) + off; }
        const int nig = WGM * nN, gid = wgid / nig, fm = gid * WGM, gsz = (nM - fm) < WGM ? (nM - fm) : WGM;
        u.pm = fm + ((wgid % nig) % gsz); u.pn = (wgid % nig) / gsz; return true;
    }
    __device__ __forceinline__ void a_ready(const Unit&) const {}
    __device__ __forceinline__ void done(const Unit&) const {}
};


__device__ __forceinline__ unsigned cvt_pk_bf16(float lo, float hi) { unsigned r; asm volatile("v_cvt_pk_bf16_f32 %0, %1, %2" : "=v"(r) : "v"(lo), "v"(hi)); return r; }
__device__ __forceinline__ float e_sigmoid(float x) { return __builtin_amdgcn_rcpf(1.f + __expf(-x)); }
__device__ __forceinline__ float e_silu(float x) { return x * e_sigmoid(x); }
__device__ __forceinline__ float bfl(unsigned w) { return __uint_as_float(w << 16); }
__device__ __forceinline__ float bfh(unsigned w) { return __uint_as_float(w & 0xffff0000u); }
enum { K_SWIGLU = 0, K_MIXA, K_MIXB, K_PLAIN, K_GATE0, K_GATE1, K_ADA };
template <int KIND> struct EpiGen {
    static constexpr bool PERM = true, AFTER_DRAIN = false;
    unsigned char* ws; int pn_off;
    __device__ __forceinline__ static void st8(bf16_t* p, const f32x4 a, const f32x4 b) {
        u32x4 w; w.x = cvt_pk_bf16(a[0], a[1]); w.y = cvt_pk_bf16(a[2], a[3]); w.z = cvt_pk_bf16(b[0], b[1]); w.w = cvt_pk_bf16(b[2], b[3]); *(u32x4*)p = w; }
    __device__ __forceinline__ void operator()(const f32x4 (&acc)[2][2][4][2], const Unit& u, int wr, int wc, int fr, int fq) const {
        const int row0 = u.pm * BM + wr * 64 + fr, cw = wc * 32 + 8 * fq, pn = u.pn + pn_off;
#pragma unroll
        for (int ai = 0; ai < 2; ++ai)
#pragma unroll
            for (int m = 0; m < 4; ++m) {
                const size_t row = (size_t)(row0 + ai * HALF + m * 16);
                if (KIND == K_SWIGLU || (KIND == K_MIXB && pn >= 4 && pn < 12)) {
                    f32x4 o0, o1;
#pragma unroll
                    for (int e = 0; e < 4; ++e) {
                        const float a0 = acc[ai][0][m][0][e], a1 = acc[ai][0][m][1][e], b0 = acc[ai][1][m][0][e], b1 = acc[ai][1][m][1][e];
                        o0[e] = (KIND == K_SWIGLU ? e_silu(a0) : a0) * b0; o1[e] = (KIND == K_SWIGLU ? e_silu(a1) : a1) * b1; }
                    bf16_t* d = (KIND == K_SWIGLU) ? (bf16_t*)(ws + WS_HID) + row * FF + 128 * pn + cw : (bf16_t*)(ws + WS_S4) + row * D + 128 * (pn - 4) + cw;
                    st8(d, o0, o1);
                } else {
#pragma unroll
                    for (int bj = 0; bj < 2; ++bj) {
                        f32x4 v0 = acc[ai][bj][m][0], v1 = acc[ai][bj][m][1];
                        bf16_t* d;
                        if (KIND == K_MIXA) {
                            d = (bf16_t*)(ws + WS_S0 + (size_t)(pn >> 2) * SLAB) + row * D + 256 * (pn & 3) + 128 * bj + cw;
                            if (pn < 2) { v0 = v0 * 0.08838834764831845f; v1 = v1 * 0.08838834764831845f; }
                            else if (pn >= 8) {
#pragma unroll
                                for (int e = 0; e < 4; ++e) { v0[e] = e_silu(v0[e]); v1[e] = e_silu(v1[e]); } }
                        } else if (KIND == K_MIXB) {
                            if (pn < 4) d = (bf16_t*)(ws + WS_S3) + row * D + 256 * pn + 128 * bj + cw;
                            else {
                                d = (bf16_t*)(ws + (pn < 16 ? WS_S0 : WS_S1)) + row * D + 256 * ((pn - 12) & 3) + 128 * bj + cw;
#pragma unroll
                                for (int e = 0; e < 4; ++e) { v0[e] = e_sigmoid(v0[e]); v1[e] = e_sigmoid(v1[e]); } }
                        } else if (KIND == K_PLAIN) {
                            d = (bf16_t*)(ws + WS_Y) + row * D + 256 * pn + 128 * bj + cw;
                        } else {
                            const size_t off = row * D + 256 * pn + 128 * bj + cw;
                            bf16_t* pa = (bf16_t*)(ws + WS_S0) + off; bf16_t* pb = (bf16_t*)(ws + WS_S1) + off;
                            const u32x4 ga = *(const u32x4*)pa;
                            if (KIND == K_GATE0) {
                                v0[0] *= bfl(ga.x); v0[1] *= bfh(ga.x); v0[2] *= bfl(ga.y); v0[3] *= bfh(ga.y); v1[0] *= bfl(ga.z); v1[1] *= bfh(ga.z); v1[2] *= bfl(ga.w); v1[3] *= bfh(ga.w);
                                d = pa;
                            } else {
                                const u32x4 gb = *(const u32x4*)pb;
                                v0[0] = bfl(ga.x) + bfl(gb.x) * v0[0]; v0[1] = bfh(ga.x) + bfh(gb.x) * v0[1]; v0[2] = bfl(ga.y) + bfl(gb.y) * v0[2]; v0[3] = bfh(ga.y) + bfh(gb.y) * v0[3];
                                v1[0] = bfl(ga.z) + bfl(gb.z) * v1[0]; v1[1] = bfh(ga.z) + bfh(gb.z) * v1[1]; v1[2] = bfl(ga.w) + bfl(gb.w) * v1[2]; v1[3] = bfh(ga.w) + bfh(gb.w) * v1[3];
                                d = pb;
                            }
                        }
                        st8(d, v0, v1);
                    }
                }
            }
    }
};

template <class Epi, class Sched, bool ALIGN_EPI = false, bool SP2 = false>
__device__ __forceinline__ void gemm_phase(PG8_LAS unsigned char* lds, const Gemm g, const Sched& S, const Epi& E) {
    const int tid = threadIdx.x, wid = __builtin_amdgcn_readfirstlane(tid >> 6), lane = tid & 63, wr = wid >> 2, wc = wid & 3, fr = lane & 15, fq = lane >> 4;
    const int K = g.K, nt = K / BK;
    unsigned voffA[2], voffB[2];
#pragma unroll
    for (int i = 0; i < 2; ++i) { int R, C; stage_rc(tid * 16 + i * 8192, R, C); const int Rb = Epi::PERM ? ((R & ~31) + perm32(R & 31)) : R;
        voffA[i] = (unsigned)(R * K + C) * 2u; voffB[i] = (unsigned)(Rb * K + C) * 2u; }
    const size_t kstep = (size_t)(BK * 2);
    const size_t hstep = (size_t)HALF * K * 2;
    const size_t tstep = 2 * hstep;
    const unsigned ldsw = (unsigned)wid * 1024u;
    const int aoff = lds_byte(wr * 64 + fr, fq * 8), boff = lds_byte(wc * 32 + fr, fq * 8);
#define PG8_SA(b, h) (((b) * 2 + (h)) * HTB)
#define PG8_SB(b, h) ((4 + (b) * 2 + (h)) * HTB)
#define PG8_STAGE(bufoff, gbase, voff) do { _Pragma("unroll") for (int _i = 0; _i < 2; ++_i) \
        __builtin_amdgcn_global_load_lds((const unsigned*)((const char*)(gbase) + (voff)[_i]), (PG8_LAS unsigned*)(lds + (bufoff) + ldsw + _i * 8192), 16, 0, 0); } while (0)
#define PG8_LDA(dst, b, h) do { _Pragma("unroll") for (int m = 0; m < 4; ++m) _Pragma("unroll") for (int k = 0; k < 2; ++k) dst[m][k] = *(const PG8_LAS bf16x8*)(lds + PG8_SA(b, h) + aoff + m * 2048 + k * 1024); } while (0)
#define PG8_LDB(dst, b, h) do { _Pragma("unroll") for (int n = 0; n < 2; ++n) _Pragma("unroll") for (int k = 0; k < 2; ++k) dst[n][k] = *(const PG8_LAS bf16x8*)(lds + PG8_SB(b, h) + boff + n * 2048 + k * 1024); } while (0)
#define PG8_MMA(ai, bj, At, Bt) do { __builtin_amdgcn_s_setprio(1); _Pragma("unroll") for (int m = 0; m < 4; ++m) _Pragma("unroll") for (int n = 0; n < 2; ++n) _Pragma("unroll") for (int k = 0; k < 2; ++k) \
        acc[ai][bj][m][n] = __builtin_amdgcn_mfma_f32_16x16x32_bf16(Bt[n][k], At[m][k], acc[ai][bj][m][n], 0, 0, 0); __builtin_amdgcn_s_setprio(0); } while (0)
#define PG8_WAIT_V(n) asm volatile("s_waitcnt vmcnt(" #n ")" ::: "memory")
#define PG8_WAIT_L(n) asm volatile("s_waitcnt lgkmcnt(" #n ")" ::: "memory")
#define PG8_BAR __builtin_amdgcn_s_barrier()
#define PG8_SCHED __builtin_amdgcn_sched_barrier(0)
    Unit cur, nxt; int ui = 0;
    if (!S.next(0, cur)) return;
    f32x4 acc[2][2][4][2];
#pragma unroll
    for (int a = 0; a < 2; ++a)
#pragma unroll
        for (int b = 0; b < 2; ++b)
#pragma unroll
            for (int m = 0; m < 4; ++m)
#pragma unroll
                for (int n = 0; n < 2; ++n) acc[a][b][m][n] = (f32x4){0.f, 0.f, 0.f, 0.f};
    bf16x8 At[4][2], B0[2][2], B1[2][2];
    const char* cA = (const char*)g.A + (size_t)cur.pm * tstep; const char* cB = (const char*)g.Bt + (size_t)cur.pn * tstep;
    S.a_ready(cur);
    if constexpr (SP2) {
        PG8_STAGE(PG8_SB(0, 0), cB, voffB); PG8_STAGE(PG8_SB(0, 1), cB + hstep, voffB); PG8_STAGE(PG8_SA(0, 0), cA, voffA); PG8_STAGE(PG8_SA(0, 1), cA + hstep, voffA);
        if (wr == 1) PG8_BAR;
        PG8_WAIT_V(2); PG8_BAR;
        PG8_STAGE(PG8_SB(1, 0), cB + kstep, voffB); PG8_STAGE(PG8_SA(1, 0), cA + kstep, voffA); PG8_STAGE(PG8_SB(1, 1), cB + hstep + kstep, voffB);
        PG8_WAIT_V(6); PG8_BAR;
    } else {
        PG8_STAGE(PG8_SB(0, 0), cB, voffB); PG8_STAGE(PG8_SA(0, 0), cA, voffA); PG8_STAGE(PG8_SB(0, 1), cB + hstep, voffB); PG8_STAGE(PG8_SA(0, 1), cA + hstep, voffA);
        if (wr == 1) PG8_BAR;
        PG8_WAIT_V(4); PG8_BAR;
        PG8_STAGE(PG8_SB(1, 0), cB + kstep, voffB); PG8_STAGE(PG8_SA(1, 0), cA + kstep, voffA); PG8_STAGE(PG8_SB(1, 1), cB + hstep + kstep, voffB);
        PG8_WAIT_V(6); PG8_BAR;
    }
    for (;;) {
        const bool has_next = S.next(ui + 1, nxt);
        const char* nA = has_next ? (const char*)g.A + (size_t)nxt.pm * tstep : cA; const char* nB = has_next ? (const char*)g.Bt + (size_t)nxt.pn * tstep : cB;
        for (int t = 0; t < nt; t += 2) {
            const bool last = (t == nt - 2);
            const char* a1 = cA + (size_t)(t + 1) * kstep;
            const char* a2 = last ? nA : cA + (size_t)(t + 2) * kstep; const char* b2 = last ? nB : cB + (size_t)(t + 2) * kstep;
            const char* a3 = a2 + kstep; const char* b3 = b2 + kstep;
            if (last && has_next) S.a_ready(nxt);
            if constexpr (SP2) {
            PG8_LDB(B0, 0, 0); PG8_LDB(B1, 0, 1); PG8_SCHED; PG8_LDA(At, 0, 0); PG8_STAGE(PG8_SA(1, 1), a1 + hstep, voffA);
            PG8_WAIT_V(8); PG8_WAIT_L(0); PG8_BAR; PG8_MMA(0, 0, At, B0); PG8_MMA(0, 1, At, B1); PG8_BAR; PG8_SCHED;
            PG8_LDA(At, 0, 1); PG8_STAGE(PG8_SB(0, 0), b2, voffB); PG8_STAGE(PG8_SB(0, 1), b2 + hstep, voffB); PG8_STAGE(PG8_SA(0, 0), a2, voffA);
            PG8_WAIT_V(8); PG8_WAIT_L(0); PG8_BAR; PG8_MMA(1, 0, At, B0); PG8_MMA(1, 1, At, B1); PG8_BAR; PG8_SCHED;
            PG8_LDB(B0, 1, 0); PG8_LDB(B1, 1, 1); PG8_SCHED; PG8_LDA(At, 1, 0); PG8_STAGE(PG8_SA(0, 1), a2 + hstep, voffA);
            PG8_WAIT_V(8); PG8_WAIT_L(0); PG8_BAR; PG8_MMA(0, 0, At, B0); PG8_MMA(0, 1, At, B1); PG8_BAR; PG8_SCHED;
            PG8_LDA(At, 1, 1); PG8_STAGE(PG8_SB(1, 0), b3, voffB); PG8_STAGE(PG8_SB(1, 1), b3 + hstep, voffB); PG8_STAGE(PG8_SA(1, 0), a3, voffA);
            PG8_WAIT_V(8); PG8_WAIT_L(0); PG8_BAR; PG8_MMA(1, 0, At, B0); PG8_MMA(1, 1, At, B1); PG8_BAR; PG8_SCHED;
            } else {
            PG8_LDB(B0, 0, 0); PG8_SCHED; PG8_LDA(At, 0, 0); PG8_STAGE(PG8_SA(1, 1), a1 + hstep, voffA);
            PG8_WAIT_L(8); PG8_BAR; PG8_WAIT_L(0); PG8_MMA(0, 0, At, B0); PG8_BAR; PG8_SCHED;
            PG8_LDB(B1, 0, 1); PG8_STAGE(PG8_SB(0, 0), b2, voffB);
            PG8_BAR; PG8_WAIT_L(0); PG8_MMA(0, 1, At, B1); PG8_BAR;
            PG8_LDA(At, 0, 1); PG8_STAGE(PG8_SA(0, 0), a2, voffA);
            PG8_BAR; PG8_WAIT_L(0); PG8_MMA(1, 0, At, B0); PG8_BAR; PG8_SCHED;
            PG8_STAGE(PG8_SB(0, 1), b2 + hstep, voffB);
            PG8_WAIT_V(6); PG8_BAR; PG8_MMA(1, 1, At, B1); PG8_BAR;
            PG8_LDB(B0, 1, 0); PG8_SCHED; PG8_LDA(At, 1, 0); PG8_STAGE(PG8_SA(0, 1), a2 + hstep, voffA);
            PG8_WAIT_L(8); PG8_BAR; PG8_WAIT_L(0); PG8_MMA(0, 0, At, B0); PG8_BAR; PG8_SCHED;
            PG8_LDB(B1, 1, 1); PG8_STAGE(PG8_SB(1, 0), b3, voffB);
            PG8_BAR; PG8_WAIT_L(0); PG8_MMA(0, 1, At, B1); PG8_BAR;
            PG8_LDA(At, 1, 1); PG8_STAGE(PG8_SA(1, 0), a3, voffA);
            PG8_BAR; PG8_WAIT_L(0); PG8_MMA(1, 0, At, B0); PG8_BAR; PG8_SCHED;
            PG8_STAGE(PG8_SB(1, 1), b3 + hstep, voffB);
            PG8_WAIT_V(6); PG8_BAR; PG8_MMA(1, 1, At, B1); PG8_BAR;
            }
        }
        if constexpr (ALIGN_EPI) { if (wr == 0) PG8_BAR; }
        if constexpr (!Epi::AFTER_DRAIN) { E(acc, cur, wr, wc, fr, fq); S.done(cur); }
        if (!has_next) break;
#pragma unroll
        for (int a = 0; a < 2; ++a)
#pragma unroll
            for (int b = 0; b < 2; ++b)
#pragma unroll
                for (int m = 0; m < 4; ++m)
#pragma unroll
                    for (int n = 0; n < 2; ++n) acc[a][b][m][n] = (f32x4){0.f, 0.f, 0.f, 0.f};
        cur = nxt; cA = nA; cB = nB; ++ui;
        if constexpr (ALIGN_EPI) { if (wr == 1) PG8_BAR; }
    }
    PG8_WAIT_V(0);
    if constexpr (!ALIGN_EPI) { if (wr == 0) PG8_BAR; }
    PG8_BAR;
    if constexpr (Epi::AFTER_DRAIN) { E.fused(acc, cur, wr, wc, fr, fq, lds, wid, lane); S.done(cur); }
#undef PG8_SA
#undef PG8_SB
#undef PG8_STAGE
#undef PG8_LDA
#undef PG8_LDB
#undef PG8_MMA
#undef PG8_WAIT_V
#undef PG8_WAIT_L
#undef PG8_BAR
#undef PG8_SCHED
}
}

constexpr int NWAVES = 8, LDS_BYTES = 147456, RING_BYTES = 131072;
constexpr size_t WB_W1IN = 0, WB_W1OUT = WB_W1IN + (size_t)2 * FF * D * 2, WB_W2IN = WB_W1OUT + (size_t)D * FF * 2, WB_W2OUT = WB_W2IN + (size_t)2 * FF * D * 2,
                 WB_MIXA = WB_W2OUT + (size_t)D * FF * 2, WB_MIXB = WB_MIXA + (size_t)3072 * D * 2, WB_BR = WB_MIXB + (size_t)5120 * D * 2, WB_MO = WB_BR + (size_t)2 * D * D * 2,
                 WB_ADA = WB_MO + (size_t)D * D * 2, WB_END = WB_ADA + (size_t)NADA * D * 2;
static_assert(WB_END <= 73 * MiB, "weights region");
#define LAS __attribute__((address_space(3)))
typedef unsigned v4u __attribute__((ext_vector_type(4)));
__device__ __forceinline__ unsigned pk2(float lo, float hi) { return (unsigned)f2bf(lo) | ((unsigned)f2bf(hi) << 16); }
constexpr int TR_SLOT = 64 * 65 * 4;
__device__ __forceinline__ void transpose_item(const float* W, int ldw, int n0, int k0, bf16_t* WT, int K, int drow0, LAS float* scr, int lane) {
    float wv[64];
    const float* wp = W + (size_t)k0 * ldw + n0 + lane;
#pragma unroll
    for (int i = 0; i < 64; ++i) wv[i] = __builtin_nontemporal_load(wp + (size_t)i * ldw);
    __builtin_amdgcn_sched_barrier(0);
#pragma unroll
    for (int i = 0; i < 64; ++i) scr[i * 65 + lane] = wv[i];
    asm volatile("s_waitcnt lgkmcnt(0)" ::: "memory");
    const int c = lane & 7;
#pragma unroll
    for (int j = 0; j < 8; ++j) { const int n = (lane >> 3) + 8 * j; const LAS float* s = scr + (8 * c) * 65 + n;
        v4u o; o.x = pk2(s[0 * 65], s[1 * 65]); o.y = pk2(s[2 * 65], s[3 * 65]); o.z = pk2(s[4 * 65], s[5 * 65]); o.w = pk2(s[6 * 65], s[7 * 65]);
        *(v4u*)(WT + (size_t)(drow0 + n) * K + k0 + 8 * c) = o; }
    asm volatile("s_waitcnt lgkmcnt(0)" ::: "memory");
}
__device__ __forceinline__ void phase_convert(const P& p, LAS unsigned char* lds, int widx, int nw, int wave, int lane, int group) {
    LAS float* scr = (LAS float*)(lds + wave * TR_SLOT);
    unsigned char* wb = p.ws + WS_WB;
    constexpr int I_FIN = (D / 64) * (2 * FF / 64), I_FOUT = (FF / 64) * (D / 64), I_MA = (D / 64) * (3072 / 64), I_MB = (D / 64) * (5120 / 64), I_SQ = (D / 64) * (D / 64);
    if (group < 0) {
        constexpr int I_ADA = (D / 64) * (NADA / 64);
        for (int it = widx; it < I_ADA; it += nw) { const int nb = NADA / 64, kb = it / nb, db = it % nb;
            transpose_item(p.w_ada, NADA, db * 64, kb * 64, (bf16_t*)(wb + WB_ADA), D, db * 64, scr, lane); }
        return;
    }
    const int nitems = group == 0 ? I_FIN : group == 1 ? I_FOUT + I_MA + I_MB : I_FIN + I_FOUT + 3 * I_SQ;
    for (int it = widx; it < nitems; it += nw) {
        int r = it;
        if (group != 1) {
            if (r < I_FIN) {
                const int which = group == 2; const int nb = 2 * FF / 64, kb = r / nb, db = r % nb, v = db * 64, tile = v >> 8, w = v & 255;
                const int n0 = (w < 128) ? 128 * tile + w : FF + 128 * tile + (w - 128);
                transpose_item(which ? p.w_ffn2_in : p.w_ffn1_in, 2 * FF, n0, kb * 64, (bf16_t*)(wb + (which ? WB_W2IN : WB_W1IN)), D, v, scr, lane); continue; }
            r -= I_FIN;
            if (r < I_FOUT) { const int nb = D / 64, kb = r / nb, db = r % nb;
                transpose_item(p.w_ffn2_out, D, db * 64, kb * 64, (bf16_t*)(wb + WB_W2OUT), FF, db * 64, scr, lane); continue; }
            r -= I_FOUT;
            { const int which = r / I_SQ; r -= which * I_SQ; const int nb = D / 64, kb = r / nb, db = r % nb;
              const float* src = which == 0 ? p.w_branch : which == 1 ? p.w_branch + (size_t)D * D : p.w_mix_out;
              bf16_t* dst = (bf16_t*)(wb + (which == 2 ? WB_MO : WB_BR)) + (which == 1 ? (size_t)D * D : 0);
              transpose_item(src, D, db * 64, kb * 64, dst, D, db * 64, scr, lane); }
            continue;
        }
        if (r < I_FOUT) { const int nb = D / 64, kb = r / nb, db = r % nb;
            transpose_item(p.w_ffn1_out, D, db * 64, kb * 64, (bf16_t*)(wb + WB_W1OUT), FF, db * 64, scr, lane); continue; }
        r -= I_FOUT;
        if (r < I_MA) { const int nb = 3072 / 64, kb = r / nb, db = r % nb;
            transpose_item(p.w_mix_in, MIXW, db * 64, kb * 64, (bf16_t*)(wb + WB_MIXA), D, db * 64, scr, lane); continue; }
        r -= I_MA;
        { const int nb = 5120 / 64, kb = r / nb, db = r % nb, v = db * 64; int n0;
            if (v < 1024) n0 = O_B + v;
            else if (v < 3072) { const int t = (v - 1024) >> 8, w = (v - 1024) & 255; n0 = (w < 128) ? O_C + 128 * t + w : O_H + 128 * t + (w - 128); }
            else if (v < 4096) n0 = O_GA + (v - 3072);
            else n0 = O_GB + (v - 4096);
            transpose_item(p.w_mix_in, MIXW, n0, kb * 64, (bf16_t*)(wb + WB_MIXB), D, v, scr, lane); }
    }
}
constexpr int ADA_ROWS = 192;
__device__ __forceinline__ void phase_ada_stage(const P& p, int gtid, int ngt) {
    bf16_t* A = (bf16_t*)(p.ws + WS_Z);
    for (int i = gtid; i < ADA_ROWS * D; i += ngt) {
        const int r = i >> 10, k = i & (D - 1);
        float v = 0.f;
        if (r < NS) v = silu_f(p.c_sample[(size_t)r * D + k]); else if (r < NS + NP) v = silu_f(p.c_prompt[(size_t)(r - NS) * D + k]);
        A[i] = f2bf(v);
    }
}
__device__ __forceinline__ void phase_conv(const P& p, int gtid, int ngt, int idx0, int idx1) {
    typedef unsigned u4_ __attribute__((ext_vector_type(4))); typedef float f4_ __attribute__((ext_vector_type(4)));
    bf16_t* B = (bf16_t*)(p.ws + WS_S3); const bf16_t* U = (const bf16_t*)(p.ws + WS_S4);
    for (int idx = idx0 + gtid; idx < idx1; idx += ngt) {
        const int m = idx >> 7, c = (idx & 127) * 8;
        const size_t e0 = (size_t)m * D + c;
        float u0[8], um1[8], um2[8], bb[8], w0[8], w1[8], w2[8];
        auto unpack = [](const u4_ v, float* f) { f[0] = __uint_as_float(v.x << 16); f[1] = __uint_as_float(v.x & 0xffff0000u); f[2] = __uint_as_float(v.y << 16); f[3] = __uint_as_float(v.y & 0xffff0000u);
                                                 f[4] = __uint_as_float(v.z << 16); f[5] = __uint_as_float(v.z & 0xffff0000u); f[6] = __uint_as_float(v.w << 16); f[7] = __uint_as_float(v.w & 0xffff0000u); };
        auto ld8 = [](const float* s, float* f) { const f4_ a = *(const f4_*)s, b = *(const f4_*)(s + 4); f[0] = a.x; f[1] = a.y; f[2] = a.z; f[3] = a.w; f[4] = b.x; f[5] = b.y; f[6] = b.z; f[7] = b.w; };
        auto st8f = [](float* d, const float* f) { *(f4_*)d = (f4_){f[0], f[1], f[2], f[3]}; *(f4_*)(d + 4) = (f4_){f[4], f[5], f[6], f[7]}; };
        unpack(*(const u4_*)(U + e0), u0); unpack(*(const u4_*)(B + e0), bb);
        ld8(p.w_conv + c, w0); ld8(p.w_conv + D + c, w1); ld8(p.w_conv + 2 * D + c, w2);
        if (m < MP) {
            const int t = m & (T - 1), n = m >> 11;
            const u4_ z4 = (u4_){0u, 0u, 0u, 0u};
            unpack(t >= 1 ? *(const u4_*)(U + e0 - D) : z4, um1);
            unpack(t >= 2 ? *(const u4_*)(U + e0 - 2 * D) : z4, um2);
            if (t >= T - 2) st8f(p.out + OUT_CONV_P + (size_t)(n * 2 + (t - (T - 2))) * D + c, u0);
        } else {
            const int n = m - MP;
            ld8(p.state_conv + (size_t)(n * 2 + 0) * D + c, um2); ld8(p.state_conv + (size_t)(n * 2 + 1) * D + c, um1);
            st8f(p.out + OUT_CONV_S + (size_t)(n * 2 + 0) * D + c, um1);
            st8f(p.out + OUT_CONV_S + (size_t)(n * 2 + 1) * D + c, u0);
        }
        float y[8];
#pragma unroll
        for (int e = 0; e < 8; ++e) y[e] = bb[e] * (w0[e] * um2[e] + w1[e] * um1[e] + w2[e] * u0[e]);
        u4_ o; o.x = pk2(y[0], y[1]); o.y = pk2(y[2], y[3]); o.z = pk2(y[4], y[5]); o.w = pk2(y[6], y[7]);
        *(u4_*)(B + e0) = o;
    }
}
__device__ __forceinline__ void gla_sample_naive_blk(const P& p, LAS float* sm, int nh, int tid) {
    LAS float *q_s = sm, *k_s = sm + DK, *a_s = sm + 2 * DK, *red = sm + 3 * DK, *op = sm + 3 * DK + 8;
    const int n = nh >> 2, h = nh & 3, dv = tid & (DV - 1), half = tid >> 8;
    const bf16_t* QK = (const bf16_t*)(p.ws + WS_S0); const bf16_t* V = (const bf16_t*)(p.ws + WS_S1); bf16_t* RY = (bf16_t*)(p.ws + WS_S2);
    const float* Z = (const float*)(p.ws + WS_Z);
    const size_t m = (size_t)MP + n;
    if (tid < DK) {
        float x = p.b_alpha[h * DK + tid];
        for (int j = 0; j < 16; ++j) x += Z[m * 16 + j] * p.w_alpha[j * 512 + h * DK + tid];
        a_s[tid] = expf(logsig_f(x) * (1.f / 16.f));
        q_s[tid] = bf2f(QK[m * D + h * DK + tid]);
        k_s[tid] = bf2f(QK[m * D + 512 + h * DK + tid]);
    }
    __syncthreads();
    const float v = bf2f(V[m * D + h * DV + dv]);
    const float* s0 = p.state_gla + (size_t)nh * DK * DV + (size_t)(64 * half) * DV + dv;
    float* s1 = p.out + OUT_GLA_S + (size_t)nh * DK * DV + (size_t)(64 * half) * DV + dv;
    float o = 0.f;
#pragma unroll 1
    for (int k8 = 0; k8 < 64; k8 += 16) {
        float sv[16];
#pragma unroll
        for (int e = 0; e < 16; ++e) sv[e] = __builtin_nontemporal_load(s0 + (size_t)(k8 + e) * DV);
#pragma unroll
        for (int e = 0; e < 16; ++e) { const int kk = 64 * half + k8 + e; const float s = a_s[kk] * sv[e] + k_s[kk] * v; __builtin_nontemporal_store(s, s1 + (size_t)(k8 + e) * DV); o += q_s[kk] * s; }
    }
    op[tid] = o;
    __syncthreads();
    float ot = 0.f;
    if (tid < DV) { ot = op[tid] + op[tid + DV]; const float ws_ = wave_sum(ot * ot); if ((tid & 63) == 0) red[tid >> 6] = ws_; }
    __syncthreads();
    if (tid < DV) {
        const float rs = rsqrtf((red[0] + red[1] + red[2] + red[3]) * (1.f / DV) + EPS);
        const size_t idx = m * D + h * DV + tid;
        RY[idx] = f2bf(ot * rs * p.g_gla[h * DV + tid] * bf2f(RY[idx]));
    }
    __syncthreads();
}

typedef float f32x16 __attribute__((ext_vector_type(16)));
typedef short s16x8 __attribute__((ext_vector_type(8)));
typedef short s16x4 __attribute__((ext_vector_type(4)));
typedef float f4 __attribute__((ext_vector_type(4)));
typedef unsigned u4 __attribute__((ext_vector_type(4)));
typedef unsigned u2 __attribute__((ext_vector_type(2)));
__device__ __forceinline__ float logsig_fast(float x) { return fminf(x, 0.f) - __logf(1.f + __expf(-fabsf(x))); }
__device__ __forceinline__ unsigned cvtpk(float lo, float hi) { unsigned r; asm volatile("v_cvt_pk_bf16_f32 %0, %1, %2" : "=v"(r) : "v"(lo), "v"(hi)); return r; }
constexpr size_t WB_PBUF = WB_ADA, WB_DEC = WB_PBUF + (size_t)NP * NH * 32 * 64 * 64 * 2;
static_assert(WB_DEC + (size_t)NP * NH * 32 * 128 * 4 <= WB_END, "P / dec buffers");
namespace gl {
constexpr int QT_LD = 136, KH_LD = 72, P_LD = 72, VT_LD = 72, O_LD = 264;
constexpr int QT_OFF = 0, KT_OFF = QT_OFF + 64 * QT_LD * 2, VT_OFF = KT_OFF + 64 * QT_LD * 2, VT_WAVE = 32 * VT_LD * 2, Z_OFF = VT_OFF + 8 * VT_WAVE, GS_OFF = Z_OFF + 4096, PREP_END = GS_OFF + 2048;
constexpr int B_QT = 0, B_KH = B_QT + 64 * QT_LD * 2, B_P = B_KH + 128 * KH_LD * 2, B_DEC = B_P + 64 * P_LD * 2, BUFSZ = B_DEC + 512, O_OFF = 2 * BUFSZ, G_OFF = O_OFF + 8 * 64 * 40 * 2  , CHAIN_END = G_OFF + 1024 + 4096;
static_assert(PREP_END <= 131072 && CHAIN_END <= 144 * 1024 - 2048, "gla lds map");
}
__device__ __forceinline__ void gla_prep_task(const P& p, LAS unsigned char* lds, int task, int tid, int lane, int wave) {
    using namespace gl;
    const int nh = task >> 5, c = task & 31, n = nh >> 2, h = nh & 3, kk = tid & 127, tg = tid >> 7, l31 = lane & 31, hi = lane >> 5;
    bf16_t* QK = (bf16_t*)(p.ws + WS_S0); bf16_t* V = (bf16_t*)(p.ws + WS_S1);
    const float* Z = (const float*)(p.ws + WS_Z);
    LAS bf16_t* Qt = (LAS bf16_t*)(lds + QT_OFF); LAS bf16_t* Kt = (LAS bf16_t*)(lds + KT_OFF); LAS bf16_t* VTw = (LAS bf16_t*)(lds + VT_OFF + wave * VT_WAVE);
    LAS float* zs = (LAS float*)(lds + Z_OFF); LAS float* gs = (LAS float*)(lds + GS_OFF);
    float wa[16];
#pragma unroll
    for (int j = 0; j < 16; ++j) wa[j] = p.w_alpha[j * 512 + h * DK + kk];
    const float ba = p.b_alpha[h * DK + kk];
    const size_t m0 = (size_t)n * T + 64 * c;
    if (tid < 256) ((LAS f4*)zs)[tid] = ((const f4*)(Z + m0 * 16))[tid];
    unsigned short qv[16], kv[16];
#pragma unroll
    for (int i = 0; i < 16; ++i) { const size_t ro = (m0 + 16 * tg + i) * D + h * DK + kk; qv[i] = QK[ro]; kv[i] = QK[ro + 512]; }
    u4 vr[4];
#pragma unroll
    for (int i = 0; i < 4; ++i) vr[i] = *(const u4*)(V + (m0 + lane) * D + h * DV + 32 * wave + 8 * i);
    __syncthreads();
    float bl[16]; float run = 0.f;
#pragma unroll
    for (int i = 0; i < 16; ++i) {
        const LAS f4* zr = (const LAS f4*)(zs + (16 * tg + i) * 16);
        float x = ba;
#pragma unroll
        for (int j4 = 0; j4 < 4; ++j4) { const f4 zq = zr[j4]; x += zq.x * wa[4 * j4] + zq.y * wa[4 * j4 + 1] + zq.z * wa[4 * j4 + 2] + zq.w * wa[4 * j4 + 3]; }
        run += logsig_fast(x) * (1.f / 16.f); bl[i] = run;
    }
    gs[tg * 128 + kk] = run;
    __syncthreads();
    const float g0 = gs[kk], g1 = gs[128 + kk], g2 = gs[256 + kk], g3 = gs[384 + kk];
    const float off = (tg > 0 ? g0 : 0.f) + (tg > 1 ? g1 : 0.f) + (tg > 2 ? g2 : 0.f);
    const float blast = (g0 + g1) + (g2 + g3);
    unsigned khp[8];
#pragma unroll
    for (int i = 0; i < 16; i += 2) {
        float kh2[2];
#pragma unroll
        for (int e = 0; e < 2; ++e) {
            const int t = 16 * tg + i + e; const float b = bl[i + e] + off;
            const float qf = bf2f(qv[i + e]), kf = bf2f(kv[i + e]);
            Qt[t * QT_LD + kk] = f2bf(qf * __expf(b));
            Kt[t * QT_LD + kk] = f2bf(kf * __expf(-b));
            kh2[e] = kf * __expf(blast - b);
        }
        khp[i >> 1] = cvtpk(kh2[0], kh2[1]);
    }
#pragma unroll
    for (int i = 0; i < 4; ++i) {
        const unsigned w4[4] = {vr[i].x, vr[i].y, vr[i].z, vr[i].w};
#pragma unroll
        for (int e = 0; e < 4; ++e) { VTw[(8 * i + 2 * e) * VT_LD + lane] = (bf16_t)(w4[e] & 0xffffu); VTw[(8 * i + 2 * e + 1) * VT_LD + lane] = (bf16_t)(w4[e] >> 16); }
    }
    __syncthreads();
    { bf16_t* kd = QK + (m0 + (kk >> 1)) * D + 512 + h * DK + (kk & 1) * 64 + 16 * tg;
      *(u4*)kd = (u4){khp[0], khp[1], khp[2], khp[3]}; *(u4*)(kd + 8) = (u4){khp[4], khp[5], khp[6], khp[7]}; }
    if (tg == 0) ((float*)(p.ws + WS_WB + WB_DEC))[(size_t)task * 128 + kk] = __expf(blast);
#pragma unroll
    for (int i = 0; i < 2; ++i) { const int pc = tid + 512 * i, t = pc >> 4, k0 = (pc & 15) * 8;
        *(u4*)(QK + (m0 + t) * D + h * DK + k0) = *(const LAS u4*)(Qt + t * QT_LD + k0); }
#pragma unroll
    for (int i = 0; i < 4; ++i) { const int q = lane + 64 * i, dvl = q >> 3, s0 = (q & 7) * 8, dv = 32 * wave + dvl;
        *(u4*)(V + (m0 + (dv >> 2)) * D + h * DV + (dv & 3) * 64 + s0) = *(const LAS u4*)(VTw + dvl * VT_LD + s0); }
    if (wave < 3) {
        const int ti = wave >= 1, si = wave == 2;
        f32x16 x;
#pragma unroll
        for (int r = 0; r < 16; ++r) x[r] = 0.f;
#pragma unroll
        for (int ks = 0; ks < 8; ++ks) {
            const s16x8 af = *(const LAS s16x8*)(Kt + (32 * si + l31) * QT_LD + 16 * ks + 8 * hi);
            const s16x8 bf = *(const LAS s16x8*)(Qt + (32 * ti + l31) * QT_LD + 16 * ks + 8 * hi);
            x = __builtin_amdgcn_mfma_f32_32x32x16_bf16(af, bf, x, 0, 0, 0);
        }
        bf16_t* pb = (bf16_t*)(p.ws + WS_WB + WB_PBUF) + (size_t)task * 4096 + (32 * ti + l31) * 64 + 32 * si + 4 * hi;
#pragma unroll
        for (int g = 0; g < 4; ++g) {
            float v4[4];
#pragma unroll
            for (int e = 0; e < 4; ++e) { const int sl = 8 * g + 4 * hi + e; v4[e] = (ti == si && sl > l31) ? 0.f : x[4 * g + e]; }
            *(u2*)(pb + 8 * g) = (u2){cvtpk(v4[0], v4[1]), cvtpk(v4[2], v4[3])};
        }
    }
}
__device__ __forceinline__ void gla_chain_blk(const P& p, LAS unsigned char* lds, int nh, int tid, int lane, int wave) {
    using namespace gl;
    const int n = nh >> 2, h = nh & 3, l31 = lane & 31, hi = lane >> 5;
    const bf16_t* QK = (const bf16_t*)(p.ws + WS_S0); const bf16_t* V = (const bf16_t*)(p.ws + WS_S1); bf16_t* RY = (bf16_t*)(p.ws + WS_S2);
    const bf16_t* PB = (const bf16_t*)(p.ws + WS_WB + WB_PBUF) + (size_t)nh * 32 * 4096; const float* DC = (const float*)(p.ws + WS_WB + WB_DEC) + (size_t)nh * 32 * 128;
    constexpr int YW_LD = 40;
    LAS bf16_t* Yw = (LAS bf16_t*)(lds + O_OFF) + wave * (64 * YW_LD);
    LAS float* ssqp = (LAS float*)(lds + G_OFF + 1024);
    LAS float* gl_ = (LAS float*)(lds + G_OFF);
    if (tid < 256) gl_[tid] = p.g_gla[h * DV + tid];
    f32x16 S[4];
#pragma unroll
    for (int j = 0; j < 4; ++j)
#pragma unroll
        for (int r = 0; r < 16; ++r) S[j][r] = 0.f;
    u4 rq[2], rk[2], rp; f4 rd; s16x8 vt[4];
    const int dvg = 32 * wave + l31;
    auto issue_ops = [&](int c) {
        const size_t m0 = (size_t)n * T + 64 * c;
#pragma unroll
        for (int i = 0; i < 2; ++i) { const int pc = tid + 512 * i;
            rq[i] = *(const u4*)(QK + (m0 + (pc >> 4)) * D + h * DK + (pc & 15) * 8);
            const int kk = pc >> 3; rk[i] = *(const u4*)(QK + (m0 + (kk >> 1)) * D + 512 + h * DK + (kk & 1) * 64 + (pc & 7) * 8); }
        rp = *(const u4*)(PB + (size_t)c * 4096 + tid * 8);
        if (tid < 32) rd = *(const f4*)(DC + c * 128 + 4 * tid);
    };
    auto issue_vt = [&](int c) {
        const size_t m0 = (size_t)n * T + 64 * c;
#pragma unroll
        for (int ks = 0; ks < 4; ++ks) vt[ks] = *(const s16x8*)(V + (m0 + (dvg >> 2)) * D + h * DV + (dvg & 3) * 64 + 16 * ks + 8 * hi);
    };
    auto commit = [&](int b) {
        LAS unsigned char* bb = lds + b * BUFSZ;
#pragma unroll
        for (int i = 0; i < 2; ++i) { const int pc = tid + 512 * i;
            *(LAS u4*)(bb + B_QT + ((pc >> 4) * QT_LD + (pc & 15) * 8) * 2) = rq[i];
            *(LAS u4*)(bb + B_KH + ((pc >> 3) * KH_LD + (pc & 7) * 8) * 2) = rk[i]; }
        *(LAS u4*)(bb + B_P + ((tid >> 3) * P_LD + (tid & 7) * 8) * 2) = rp;
        if (tid < 32) *(LAS f4*)(bb + B_DEC + 16 * tid) = rd;
    };
    issue_ops(0); commit(0); issue_ops(1); issue_vt(0);
    __syncthreads();
    for (int c = 0; c < T / 64; ++c) {
        const size_t m0 = (size_t)n * T + 64 * c;
        LAS unsigned char* bb = lds + (c & 1) * BUFSZ;
        const LAS bf16_t* Qt = (const LAS bf16_t*)(bb + B_QT); const LAS bf16_t* Kh = (const LAS bf16_t*)(bb + B_KH); const LAS bf16_t* Pm = (const LAS bf16_t*)(bb + B_P);
        const LAS float* dec = (const LAS float*)(bb + B_DEC);
        bf16_t* ybase = RY + m0 * D + h * DV + 32 * wave;
        u4 rr[4];
#pragma unroll
        for (int i = 0; i < 4; ++i) { const int q = lane + 64 * i; rr[i] = *(const u4*)(ybase + (size_t)(q >> 2) * D + 8 * (q & 3)); }
        f32x16 o0, o1;
#pragma unroll
        for (int r = 0; r < 16; ++r) { o0[r] = 0.f; o1[r] = 0.f; }
#pragma unroll
        for (int ks = 0; ks < 2; ++ks) o0 = __builtin_amdgcn_mfma_f32_32x32x16_bf16(vt[ks], *(const LAS s16x8*)(Pm + l31 * P_LD + 16 * ks + 8 * hi), o0, 0, 0, 0);
#pragma unroll
        for (int ks = 0; ks < 4; ++ks) o1 = __builtin_amdgcn_mfma_f32_32x32x16_bf16(vt[ks], *(const LAS s16x8*)(Pm + (32 + l31) * P_LD + 16 * ks + 8 * hi), o1, 0, 0, 0);
#pragma unroll
        for (int j = 0; j < 4; ++j)
#pragma unroll
            for (int s2 = 0; s2 < 2; ++s2) {
                union { unsigned u[4]; s16x8 v; } sfr;
#pragma unroll
                for (int e = 0; e < 4; ++e) sfr.u[e] = cvtpk(S[j][8 * s2 + 2 * e], S[j][8 * s2 + 2 * e + 1]);
                const int kb = 32 * j + 16 * s2 + 4 * hi;
                union { s16x4 h2[2]; s16x8 v; } q0, q1;
                q0.h2[0] = *(const LAS s16x4*)(Qt + l31 * QT_LD + kb); q0.h2[1] = *(const LAS s16x4*)(Qt + l31 * QT_LD + kb + 8);
                q1.h2[0] = *(const LAS s16x4*)(Qt + (32 + l31) * QT_LD + kb); q1.h2[1] = *(const LAS s16x4*)(Qt + (32 + l31) * QT_LD + kb + 8);
                o0 = __builtin_amdgcn_mfma_f32_32x32x16_bf16(sfr.v, q0.v, o0, 0, 0, 0);
                o1 = __builtin_amdgcn_mfma_f32_32x32x16_bf16(sfr.v, q1.v, o1, 0, 0, 0);
            }
        __builtin_amdgcn_sched_barrier(0);
#pragma unroll
        for (int j = 0; j < 4; ++j) {
            if (j == 2) __builtin_amdgcn_sched_barrier(0);
#pragma unroll
            for (int g = 0; g < 4; ++g) { const f4 d4 = *(const LAS f4*)(dec + 32 * j + 8 * g + 4 * hi);
                S[j][4 * g] *= d4.x; S[j][4 * g + 1] *= d4.y; S[j][4 * g + 2] *= d4.z; S[j][4 * g + 3] *= d4.w; }
#pragma unroll
            for (int ks = 0; ks < 4; ++ks) S[j] = __builtin_amdgcn_mfma_f32_32x32x16_bf16(*(const LAS s16x8*)(Kh + (32 * j + l31) * KH_LD + 16 * ks + 8 * hi), vt[ks], S[j], 0, 0, 0);
        }
        __builtin_amdgcn_sched_barrier(0);
        if (c + 1 < T / 64) issue_vt(c + 1);
        float s0 = 0.f, s1 = 0.f;
#pragma unroll
        for (int r = 0; r < 16; ++r) { s0 += o0[r] * o0[r]; s1 += o1[r] * o1[r]; }
        s0 += __shfl_xor(s0, 32); s1 += __shfl_xor(s1, 32);
        LAS float* sq = ssqp + (c & 1) * 512;
        if (hi == 0) { sq[wave * 64 + l31] = s0; sq[wave * 64 + 32 + l31] = s1; }
        if (c + 1 < T / 64) { commit((c + 1) & 1); if (c + 2 < T / 64) issue_ops(c + 2); }
        __syncthreads();
        float t0 = 0.f, t1 = 0.f;
#pragma unroll
        for (int w8 = 0; w8 < 8; ++w8) { t0 += sq[w8 * 64 + l31]; t1 += sq[w8 * 64 + 32 + l31]; }
        const float rs0 = rsqrtf(t0 * (1.f / DV) + EPS), rs1 = rsqrtf(t1 * (1.f / DV) + EPS);
#pragma unroll
        for (int g = 0; g < 4; ++g) {
            const f4 gv = *(const LAS f4*)(gl_ + 32 * wave + 8 * g + 4 * hi);
            *(LAS u2*)(Yw + l31 * YW_LD + 8 * g + 4 * hi) = (u2){cvtpk(o0[4 * g] * rs0 * gv.x, o0[4 * g + 1] * rs0 * gv.y), cvtpk(o0[4 * g + 2] * rs0 * gv.z, o0[4 * g + 3] * rs0 * gv.w)};
            *(LAS u2*)(Yw + (32 + l31) * YW_LD + 8 * g + 4 * hi) = (u2){cvtpk(o1[4 * g] * rs1 * gv.x, o1[4 * g + 1] * rs1 * gv.y), cvtpk(o1[4 * g + 2] * rs1 * gv.z, o1[4 * g + 3] * rs1 * gv.w)};
        }
        asm volatile("s_waitcnt lgkmcnt(0)" ::: "memory");
#pragma unroll
        for (int i = 0; i < 4; ++i) {
            const int q = lane + 64 * i;
            const u4 yv = *(const LAS u4*)(Yw + (q >> 2) * YW_LD + 8 * (q & 3));
            u4 yo;
#pragma unroll
            for (int e = 0; e < 4; ++e) yo[e] = cvtpk(__uint_as_float(yv[e] << 16) * __uint_as_float(rr[i][e] << 16), __uint_as_float(yv[e] & 0xffff0000u) * __uint_as_float(rr[i][e] & 0xffff0000u));
            *(u4*)(ybase + (size_t)(q >> 2) * D + 8 * (q & 3)) = yo;
        }
        asm volatile("s_waitcnt lgkmcnt(0)" ::: "memory");
    }
    float* gsout = p.out + OUT_GLA_P + (size_t)nh * DK * DV;
#pragma unroll
    for (int j = 0; j < 4; ++j)
#pragma unroll
        for (int r = 0; r < 16; ++r) gsout[(size_t)(32 * j + (r & 3) + 8 * (r >> 2) + 4 * hi) * DV + dvg] = S[j][r];
    __syncthreads();
}

#define XB_XCNT(j)  (512  + 64 * (j))
#define XB_XSUB(j)  (1536 + 64 * (j))
#define XB_XGEN(j)  (2560 + 64 * (j))
#define XB_TOP      3584
#define XB_TOPGEN   3648
__device__ __forceinline__ unsigned xb_ld(unsigned* p)              { return __hip_atomic_load(p, __ATOMIC_RELAXED, __HIP_MEMORY_SCOPE_AGENT); }
__device__ __forceinline__ unsigned xb_add(unsigned* p, unsigned v) { return __hip_atomic_fetch_add(p, v, __ATOMIC_RELAXED, __HIP_MEMORY_SCOPE_AGENT); }
__device__ __forceinline__ unsigned xb_xcc_id() { return (unsigned)__builtin_amdgcn_s_getreg((3 << 11) | 20) & 0xFu; }
__device__ __forceinline__ void xcd_barrier(unsigned* bar, unsigned x, volatile LAS unsigned* st  ) {
    __syncthreads();
    if (threadIdx.x == 0) {
        __builtin_amdgcn_s_waitcnt(0);
        unsigned nloc = st[0], nx = st[1];
        if (nloc == 0u) {
            const unsigned G = gridDim.x; unsigned sum, cnt, mine, sp = 0u;
            for (;;) {
                sum = 0u; cnt = 0u; mine = 0u;
#pragma unroll
                for (unsigned j = 0; j < 16; ++j) { const unsigned c = xb_ld(&bar[XB_XCNT(j)]); sum += c; cnt += (c > 0u) ? 1u : 0u; mine = (j == x) ? c : mine; }
                if (sum == G || ++sp > (1u << 20)) break;
                __builtin_amdgcn_s_sleep(4);
            }
            nloc = mine > 0u ? mine : 1u; nx = cnt > 0u ? cnt : 1u; st[0] = nloc; st[1] = nx;
        }
        const unsigned old = xb_add(&bar[XB_XSUB(x)], 1u);
        __builtin_amdgcn_fence(__ATOMIC_ACQUIRE, "agent");
        const unsigned gen = old / nloc;
        if (old + 1u == (gen + 1u) * nloc) {
            __builtin_amdgcn_fence(__ATOMIC_RELEASE, "agent");
            asm volatile("s_waitcnt vmcnt(0)" ::: "memory");
            const unsigned og = xb_add(&bar[XB_TOP], 1u);
            const unsigned tg = og / nx;
            if (og + 1u == (tg + 1u) * nx) xb_add(&bar[XB_TOPGEN], 1u);
            else { unsigned sp = 0u; while (xb_ld(&bar[XB_TOPGEN]) == tg && ++sp < (1u << 22)) __builtin_amdgcn_s_sleep(4); }
            asm volatile("s_waitcnt vmcnt(0)" ::: "memory");
        } else {
            unsigned sp = 0u; while (xb_ld(&bar[XB_TOPGEN]) == gen && ++sp < (1u << 20)) __builtin_amdgcn_s_sleep(32);
            asm volatile("s_waitcnt vmcnt(0)" ::: "memory");
        }
    }
    __syncthreads();
}

enum { PH_ADA = 0, PH_NORM0, PH_FFN1_IN, PH_FFN1_OUT, PH_NORM1, PH_MIXA, PH_GLAPREP, PH_GLA, PH_MIXB2, PH_BR, PH_MIXOUT, PH_NORM2, PH_FFN2_IN, PH_FFN2_OUT, PH_NORM3, PH_COUNT };
struct Args { P p; int ph_lo, ph_hi; };
typedef short sm_bf16x8 __attribute__((ext_vector_type(8)));
typedef float sm_f4 __attribute__((ext_vector_type(4)));
typedef unsigned sm_u2 __attribute__((ext_vector_type(2)));
template <int KIND>
__device__ __forceinline__ void sample_store(const P& p, int pn, int cw  , size_t row, const sm_f4 (&v)[2]) {
    using namespace pg8;
    unsigned char* ws = p.ws;
    if (KIND == K_ADA) {
        const int r = (int)row; if (r >= NS + NP) return;
        float* ada = (float*)(ws + WS_ADA) + (size_t)(r < NS ? NP + r : r - NS) * NADA;
#pragma unroll
        for (int bj = 0; bj < 2; ++bj) {
            const int n0 = 256 * pn + 128 * bj + cw, sub = n0 / (3 * D), which = (n0 - sub * 3 * D) >> 10, dcol = n0 & (D - 1);
            const sm_f4 bn = *(const sm_f4*)(p.b_ada + n0);
            sm_f4 mul = (sm_f4){1.f, 1.f, 1.f, 1.f}; float add = 0.f;
            if (which == 1) { mul = *(const sm_f4*)(p.g_pre + sub * D + dcol); add = 1.f; }
            else if (which == 2) mul = *(const sm_f4*)(p.g_post + sub * D + dcol) * (sub == 1 ? 1.0f : 0.5f);
            *(sm_f4*)(ada + n0) = (v[bj] + bn + add) * mul;
        }
        return;
    }
    auto st4 = [](bf16_t* d, const sm_f4 x) { const sm_u2 w = (sm_u2){cvt_pk_bf16(x[0], x[1]), cvt_pk_bf16(x[2], x[3])}; if (KIND == K_PLAIN) st_wt((void*)d, w); else *(sm_u2*)d = w; };
    if (KIND == K_SWIGLU || (KIND == K_MIXB && pn >= 4 && pn < 12)) {
        sm_f4 o;
#pragma unroll
        for (int e = 0; e < 4; ++e) o[e] = (KIND == K_SWIGLU ? e_silu(v[0][e]) : v[0][e]) * v[1][e];
        st4((KIND == K_SWIGLU) ? (bf16_t*)(ws + WS_HID) + row * FF + 128 * pn + cw : (bf16_t*)(ws + WS_S4) + row * D + 128 * (pn - 4) + cw, o);
        return;
    }
#pragma unroll
    for (int bj = 0; bj < 2; ++bj) {
        sm_f4 x = v[bj]; bf16_t* d;
        if (KIND == K_MIXA) {
            d = (bf16_t*)(ws + WS_S0 + (size_t)(pn >> 2) * SLAB) + row * D + 256 * (pn & 3) + 128 * bj + cw;
            if (pn < 2) x = x * 0.08838834764831845f;
            else if (pn >= 8) {
#pragma unroll
                for (int e = 0; e < 4; ++e) x[e] = e_silu(x[e]); }
        } else if (KIND == K_MIXB) {
            if (pn < 4) d = (bf16_t*)(ws + WS_S3) + row * D + 256 * pn + 128 * bj + cw;
            else { d = (bf16_t*)(ws + (pn < 16 ? WS_S0 : WS_S1)) + row * D + 256 * ((pn - 12) & 3) + 128 * bj + cw;
#pragma unroll
                for (int e = 0; e < 4; ++e) x[e] = e_sigmoid(x[e]); }
        } else if (KIND == K_PLAIN) {
            d = (bf16_t*)(ws + WS_Y) + row * D + 256 * pn + 128 * bj + cw;
        } else {
            const size_t off = row * D + 256 * pn + 128 * bj + cw;
            bf16_t* pa = (bf16_t*)(ws + WS_S0) + off; bf16_t* pb = (bf16_t*)(ws + WS_S1) + off;
            const sm_u2 ga = *(const sm_u2*)pa;
            if (KIND == K_GATE0) { x[0] *= bfl(ga.x); x[1] *= bfh(ga.x); x[2] *= bfl(ga.y); x[3] *= bfh(ga.y); d = pa; }
            else { const sm_u2 gb = *(const sm_u2*)pb;
                x[0] = bfl(ga.x) + bfl(gb.x) * x[0]; x[1] = bfh(ga.x) + bfh(gb.x) * x[1]; x[2] = bfl(ga.y) + bfl(gb.y) * x[2]; x[3] = bfh(ga.y) + bfh(gb.y) * x[3]; d = pb; }
        }
        st4(d, x);
    }
}
template <int NS>
__device__ __forceinline__ void sample_batch(const bf16_t* ap, const bf16_t* bp, int K, int k0, sm_f4 (&acc)[4][2]) {
    sm_bf16x8 af[4][NS], bf[2][NS];
#pragma unroll
    for (int m = 0; m < 4; ++m)
#pragma unroll
        for (int s = 0; s < NS; ++s) af[m][s] = *(const sm_bf16x8*)(ap + (size_t)(16 * m) * K + k0 + 32 * s);
#pragma unroll
    for (int bj = 0; bj < 2; ++bj)
#pragma unroll
        for (int s = 0; s < NS; ++s) bf[bj][s] = *(const sm_bf16x8*)(bp + (size_t)(128 * bj) * K + k0 + 32 * s);
    __builtin_amdgcn_sched_barrier(0);
#pragma unroll
    for (int s = 0; s < NS; ++s)
#pragma unroll
        for (int m = 0; m < 4; ++m)
#pragma unroll
            for (int bj = 0; bj < 2; ++bj) acc[m][bj] = __builtin_amdgcn_mfma_f32_16x16x32_bf16(bf[bj][s], af[m][s], acc[m][bj], 0, 0, 0);
}
template <int NS>
__device__ __forceinline__ void sample_batch_f32w(const float* const (&crow)[4], const float* wp  , int ldw, int k0, sm_f4 (&acc)[4][2]) {
    sm_f4 cv[4][NS][2]; float wv[2][NS][8];
#pragma unroll
    for (int m = 0; m < 4; ++m)
#pragma unroll
        for (int s = 0; s < NS; ++s)
#pragma unroll
            for (int h2 = 0; h2 < 2; ++h2) cv[m][s][h2] = crow[m] ? *(const sm_f4*)(crow[m] + k0 + 32 * s + 4 * h2) : (sm_f4){0.f, 0.f, 0.f, 0.f};
#pragma unroll
    for (int bj = 0; bj < 2; ++bj)
#pragma unroll
        for (int s = 0; s < NS; ++s)
#pragma unroll
            for (int j = 0; j < 8; ++j) wv[bj][s][j] = wp[(size_t)(k0 + 32 * s + j) * ldw + 128 * bj];
    __builtin_amdgcn_sched_barrier(0);
#pragma unroll
    for (int s = 0; s < NS; ++s) {
        sm_bf16x8 af[4];
#pragma unroll
        for (int m = 0; m < 4; ++m) { union { unsigned u[4]; sm_bf16x8 v; } t;
#pragma unroll
            for (int e = 0; e < 2; ++e) { t.u[e] = pg8::cvt_pk_bf16(pg8::e_silu(cv[m][s][0][2 * e]), pg8::e_silu(cv[m][s][0][2 * e + 1])); t.u[2 + e] = pg8::cvt_pk_bf16(pg8::e_silu(cv[m][s][1][2 * e]), pg8::e_silu(cv[m][s][1][2 * e + 1])); }
            af[m] = t.v; }
#pragma unroll
        for (int bj = 0; bj < 2; ++bj) {
            union { unsigned u[4]; sm_bf16x8 v; } bf;
#pragma unroll
            for (int e = 0; e < 4; ++e) bf.u[e] = pg8::cvt_pk_bf16(wv[bj][s][2 * e], wv[bj][s][2 * e + 1]);
#pragma unroll
            for (int m = 0; m < 4; ++m) acc[m][bj] = __builtin_amdgcn_mfma_f32_16x16x32_bf16(bf.v, af[m], acc[m][bj], 0, 0, 0);
        }
    }
}
template <int KIND, int K>
__device__ __forceinline__ int sample_tasks(const P& p, LAS unsigned char* lds, const bf16_t* A  , const bf16_t* Bt, int N, int wave, int lane, int pn_off, int nrh, size_t row_base, bool from_last, const float* Wf32 = nullptr, int ldw = 0, int nlast = 0  ) {
    constexpr int KS = K / 256;
    static_assert(KS == 4 || KS == 11, "sample_tasks: K is 1024 or 2816");
    const int fr = lane & 15, fq = lane >> 4, ntask = (N >> 8) * 8 * nrh, G = (int)gridDim.x;
    LAS float* part = (LAS float*)lds; int ndone = 0;
    const bool xcd_map = (KIND == pg8::K_ADA) && (G % 8 == 0);
    const int xg = (int)blockIdx.x & 7, yg = (int)blockIdx.x >> 3, ngrp = (N >> 8) * 8, per_x = ((ngrp + 7) >> 3) * nrh;
    const int nl = (from_last && nlast > 0) ? nlast : G;
    if (from_last && G - 1 - (int)blockIdx.x >= nl) return 0;
    for (int t = xcd_map ? yg : (from_last ? G - 1 - (int)blockIdx.x : (int)blockIdx.x); t < (xcd_map ? per_x : ntask); t += (xcd_map ? (G >> 3) : nl)) {
        int rh, ti;
        if (xcd_map) { rh = t % nrh; ti = (t / nrh) * 8 + xg; if (ti >= ngrp) continue; } else { rh = t % nrh; ti = t / nrh; }
        const int pn = ti >> 3, i8 = ti & 7;
        const bf16_t* ap = A + (size_t)(64 * rh + fr) * K + 8 * fq + wave * (KS * 32);
        const bf16_t* bp = Bt + (size_t)(256 * pn + 16 * i8 + fr) * K + 8 * fq + wave * (KS * 32);
        sm_f4 acc[4][2];
#pragma unroll
        for (int m = 0; m < 4; ++m)
#pragma unroll
            for (int bj = 0; bj < 2; ++bj) acc[m][bj] = (sm_f4){0.f, 0.f, 0.f, 0.f};
        if (KIND == pg8::K_ADA) {
            const float* wp = Wf32 + (size_t)(wave * (KS * 32) + 8 * fq) * ldw + 256 * pn + 16 * i8 + fr;
            const float* crow[4];
#pragma unroll
            for (int m = 0; m < 4; ++m) { const int r = 64 * rh + 16 * m + fr;
                crow[m] = r < NS ? p.c_sample + (size_t)r * D + wave * (KS * 32) + 8 * fq : r < NS + NP ? p.c_prompt + (size_t)(r - NS) * D + wave * (KS * 32) + 8 * fq : nullptr; }
            sample_batch_f32w<2>(crow, wp, ldw, 0, acc); sample_batch_f32w<2>(crow, wp, ldw, 64, acc);
        } else if (KS == 4) sample_batch<4>(ap, bp, K, 0, acc);
        else { sample_batch<6>(ap, bp, K, 0, acc); sample_batch<5>(ap, bp, K, 192, acc); }
#pragma unroll
        for (int m = 0; m < 4; ++m)
#pragma unroll
            for (int bj = 0; bj < 2; ++bj)
#pragma unroll
                for (int e = 0; e < 4; ++e) part[((((wave * 4 + m) * 2 + bj) * 4 + e) << 6) + lane] = acc[m][bj][e];
        __syncthreads();
        if (wave < 4) {
            sm_f4 v[2];
#pragma unroll
            for (int bj = 0; bj < 2; ++bj)
#pragma unroll
                for (int e = 0; e < 4; ++e) {
                    float s = 0.f;
#pragma unroll
                    for (int q = 0; q < 8; ++q) s += part[((((q * 4 + wave) * 2 + bj) * 4 + e) << 6) + lane];
                    v[bj][e] = s;
                }
            sample_store<KIND>(p, pn + pn_off, 16 * i8 + 4 * fq, row_base + 64 * rh + 16 * wave + fr, v);
        }
        __syncthreads(); ++ndone;
    }
    return ndone;
}
template <int KIND, int K>
__device__ __forceinline__ void run_gemm(const Args& a, LAS unsigned char* lds, const bf16_t* A, const bf16_t* Bt, int N, int b0 = 0, int pn_off = 0, int cgroup = -1, bool with_sample = true) {
    const int Gs = (int)gridDim.x - b0, cs = (int)blockIdx.x - b0;
    pg8::Gemm g{A, Bt, MP, N, K}; pg8::StaticOrder S; S.init(MP, N, Gs, cs);
    pg8::EpiGen<KIND> E{a.p.ws, pn_off};
    pg8::gemm_phase<pg8::EpiGen<KIND>, pg8::StaticOrder, true, true>(lds, g, S, E);
    const int wave = __builtin_amdgcn_readfirstlane(threadIdx.x >> 6), lane = threadIdx.x & 63;
    if (with_sample) { const int rem_ = ((MP >> 8) * (N >> 8)) % Gs;
        sample_tasks<KIND, K>(a.p, lds, A + (size_t)MP * K, Bt, N, wave, lane, pn_off, 2, (size_t)MP, true, nullptr, 0, rem_ ? Gs - rem_ : 0); }
    if (cgroup >= 0) {
        const int rem = ((MP >> 8) * (N >> 8)) % Gs;
        if (rem != 0 && cs >= rem) { __syncthreads(); phase_convert(a.p, lds, (cs - rem) * NWAVES + wave, (Gs - rem) * NWAVES, wave, lane, cgroup); }
    }
}
template <int K>
__device__ __forceinline__ void deferred_sample_tasks(const Args& a, LAS unsigned char* lds, const bf16_t* A, const bf16_t* Bt, unsigned* cnt, int wave, int lane) {
    const int nd = sample_tasks<pg8::K_PLAIN, K>(a.p, lds, A + (size_t)MP * K, Bt, D, wave, lane, 0, 2, (size_t)MP, true);
    if (nd > 0) {
        asm volatile("s_waitcnt vmcnt(0)" ::: "memory");
        __syncthreads();
        if (threadIdx.x == 0) __hip_atomic_fetch_add(cnt, (unsigned)nd, __ATOMIC_RELAXED, __HIP_MEMORY_SCOPE_AGENT);
    }
}
__global__ void __launch_bounds__(NWAVES * 64, 2) mega(Args a) {
    extern __shared__ __attribute__((aligned(16))) unsigned char lds_raw[];
    LAS unsigned char* lds = (LAS unsigned char*)lds_raw;
    cg::grid_group grid = cg::this_grid();
    const int tid = threadIdx.x, lane = tid & 63, wave = __builtin_amdgcn_readfirstlane(tid >> 6);
    const int gw = blockIdx.x * NWAVES + wave, ngw = gridDim.x * NWAVES;
    const int gtid = blockIdx.x * (NWAVES * 64) + tid, ngt = gridDim.x * NWAVES * 64;
    unsigned char* ws = a.p.ws; unsigned char* wb = ws + WS_WB;
    const bf16_t *XN = (const bf16_t*)(ws + WS_XN), *HID = (const bf16_t*)(ws + WS_HID), *S1 = (const bf16_t*)(ws + WS_S1), *S2 = (const bf16_t*)(ws + WS_S2), *S3 = (const bf16_t*)(ws + WS_S3);
#define IN(k) (a.ph_lo <= (k) && (k) < a.ph_hi)
#define SEAM(k) do { if (IN(k) && IN((k) + 1)) { asm volatile("s_waitcnt vmcnt(0)" ::: "memory"); xcd_barrier(bar, xcc, xb_st); } } while (0)
    unsigned* bar = (unsigned*)(a.p.ws + WS_CTL);
    const unsigned xcc = xb_xcc_id(); volatile LAS unsigned* xb_st = (volatile LAS unsigned*)(lds + 147424);
    if (tid == 0) { xb_st[0] = 0u; xb_st[1] = 0u; }
    if (blockIdx.x == 0 && tid < 64) {
        if (tid < 16) { __hip_atomic_store(bar + XB_XCNT(tid), 0u, __ATOMIC_RELAXED, __HIP_MEMORY_SCOPE_AGENT); __hip_atomic_store(bar + XB_XSUB(tid), 0u, __ATOMIC_RELAXED, __HIP_MEMORY_SCOPE_AGENT);
            __hip_atomic_store(bar + XB_XGEN(tid), 0u, __ATOMIC_RELAXED, __HIP_MEMORY_SCOPE_AGENT); }
        else if (tid == 16) { __hip_atomic_store(bar + XB_TOP, 0u, __ATOMIC_RELAXED, __HIP_MEMORY_SCOPE_AGENT); __hip_atomic_store(bar + XB_TOPGEN, 0u, __ATOMIC_RELAXED, __HIP_MEMORY_SCOPE_AGENT); }
        else if (tid >= 18 && tid < 21) __hip_atomic_store(bar + 64 * (tid - 16), 0u, __ATOMIC_RELAXED, __HIP_MEMORY_SCOPE_AGENT);
    }
    grid.sync();
    if (tid == 0) (void)xb_add(&bar[XB_XCNT(xcc)], 1u);
    if (IN(PH_ADA)) {
        sample_tasks<pg8::K_ADA, D>(a.p, lds, nullptr, nullptr, NADA, wave, lane, 0, 3, 0, false, a.p.w_ada, NADA);
        __syncthreads();
        phase_convert(a.p, lds, gw, ngw, wave, lane, 0);
    }
    SEAM(PH_ADA);
    if (IN(PH_NORM0)) norm_phase<0>(a.p, wave, lane, nullptr);
    SEAM(PH_NORM0);
    if (IN(PH_FFN1_IN)) run_gemm<pg8::K_SWIGLU, D>(a, lds, XN, (const bf16_t*)(wb + WB_W1IN), 2 * FF, 0, 0, 1);
    SEAM(PH_FFN1_IN);
    if (IN(PH_FFN1_OUT)) run_gemm<pg8::K_PLAIN, FF>(a, lds, HID, (const bf16_t*)(wb + WB_W1OUT), D, 0, 0, -1, false);
    SEAM(PH_FFN1_OUT);
    if (IN(PH_NORM1)) {
        deferred_sample_tasks<FF>(a, lds, HID, (const bf16_t*)(wb + WB_W1OUT), bar + 128, wave, lane);
        LAS float* wzt = (LAS float*)lds;
        __syncthreads();
        for (int i = tid; i < D * 16; i += NWAVES * 64) { const int c = i >> 4, q = i & 15; wzt[q * D + c] = a.p.w_mix_in[(size_t)c * MIXW + O_Z + q]; }
        __syncthreads();
        norm_phase<1>(a.p, wave, lane, wzt, bar + 128, 64u, 5);
        __syncthreads();
    }
    SEAM(PH_NORM1);
    if (IN(PH_MIXA)) run_gemm<pg8::K_MIXA, D>(a, lds, XN, (const bf16_t*)(wb + WB_MIXA), 3072, 0, 0, -1, false);
    SEAM(PH_MIXA);
    if (IN(PH_GLAPREP)) {
        sample_tasks<pg8::K_MIXA, D>(a.p, lds, XN + (size_t)MP * D, (const bf16_t*)(wb + WB_MIXA), 3072, wave, lane, 0, 2, (size_t)MP, true);
        __syncthreads();
        if (gridDim.x == 256 && NP == 8) { for (int j = 0; j < NH; ++j) gla_prep_task(a.p, lds, ((((int)blockIdx.x & 7) * NH + j) << 5) + ((int)blockIdx.x >> 3), tid, lane, wave); }
        else for (int task = (int)blockIdx.x; task < NP * NH * 32; task += (int)gridDim.x) gla_prep_task(a.p, lds, task, tid, lane, wave);
        __syncthreads();
    }
    SEAM(PH_GLAPREP);
    if (IN(PH_GLA)) {
        __syncthreads();
        if (blockIdx.x < NP * NH) gla_chain_blk(a.p, lds, (gridDim.x == 256 && NP == 8) ? ((int)blockIdx.x & 7) * NH + ((int)blockIdx.x >> 3) : (int)blockIdx.x, tid, lane, wave);
        else {
            run_gemm<pg8::K_MIXB, D>(a, lds, XN, (const bf16_t*)(wb + WB_MIXB), 3072, NP * NH, 0, 2);
            for (int task = (int)blockIdx.x - NP * NH; task < NS * NH; task += (int)gridDim.x - NP * NH) { __syncthreads(); gla_sample_naive_blk(a.p, (LAS float*)lds, task, tid); }
        }
    }
    SEAM(PH_GLA);
    if (IN(PH_MIXB2)) {
        constexpr int CH = MT * (D / 8) / 2;
        const int half_gtid = (int)(blockIdx.x >> 1) * (NWAVES * 64) + tid, half_ngt = (int)(gridDim.x >> 1) * NWAVES * 64;
        if (blockIdx.x & 1) phase_conv(a.p, half_gtid, half_ngt, 0, CH);
        run_gemm<pg8::K_MIXB, D>(a, lds, XN, (const bf16_t*)(wb + WB_MIXB) + (size_t)3072 * D, 2048, 0, 12);
        if (!(blockIdx.x & 1)) phase_conv(a.p, half_gtid, half_ngt, CH, MT * (D / 8));
    }
    SEAM(PH_MIXB2);
    if (IN(PH_BR)) {
        run_gemm<pg8::K_GATE0, D>(a, lds, S2, (const bf16_t*)(wb + WB_BR), D);
        run_gemm<pg8::K_GATE1, D>(a, lds, S3, (const bf16_t*)(wb + WB_BR) + (size_t)D * D, D);
    }
    SEAM(PH_BR);
    if (IN(PH_MIXOUT)) run_gemm<pg8::K_PLAIN, D>(a, lds, S1, (const bf16_t*)(wb + WB_MO), D, 0, 0, -1, false);
    SEAM(PH_MIXOUT);
    if (IN(PH_NORM2)) { deferred_sample_tasks<D>(a, lds, S1, (const bf16_t*)(wb + WB_MO), bar + 192, wave, lane); norm_phase<2>(a.p, wave, lane, nullptr, bar + 192, 64u, 3); }
    SEAM(PH_NORM2);
    if (IN(PH_FFN2_IN)) run_gemm<pg8::K_SWIGLU, D>(a, lds, XN, (const bf16_t*)(wb + WB_W2IN), 2 * FF);
    SEAM(PH_FFN2_IN);
    if (IN(PH_FFN2_OUT)) run_gemm<pg8::K_PLAIN, FF>(a, lds, HID, (const bf16_t*)(wb + WB_W2OUT), D, 0, 0, -1, false);
    SEAM(PH_FFN2_OUT);
    if (IN(PH_NORM3)) { deferred_sample_tasks<FF>(a, lds, HID, (const bf16_t*)(wb + WB_W2OUT), bar + 256, wave, lane); norm_phase<3>(a.p, wave, lane, nullptr, bar + 256, 64u, 10); }
#undef IN
#undef SEAM
}

#ifndef MK_PER_PHASE
#define MK_PER_PHASE 0
#endif
extern "C" void kernel_launch(void* const* d_in, const int* in_sizes, int n_in, void* d_out, int out_size, void* d_ws, size_t ws_size, hipStream_t stream) {
    if (n_in != 21 || ws_size < WS_END || out_size != (int)(OUT_CONV_S + (size_t)NS * 2 * D)) {
        fprintf(stderr, "kernel_launch: unexpected sizes n_in=%d ws=%zu need=%zu out=%d\n", n_in, ws_size, (size_t)WS_END, out_size);
        return;
    }
    static int grid = 0;
    if (grid == 0) {
        int dev = 0, cus = 0, per_cu = 0;
        hipGetDevice(&dev); hipDeviceGetAttribute(&cus, hipDeviceAttributeMultiprocessorCount, dev);
        hipFuncSetAttribute((const void*)mega, hipFuncAttributeMaxDynamicSharedMemorySize, LDS_BYTES);
        hipOccupancyMaxActiveBlocksPerMultiprocessor(&per_cu, (const void*)mega, NWAVES * 64, LDS_BYTES);
        if (per_cu < 1) { fprintf(stderr, "kernel_launch: occupancy query says %d blocks per CU\n", per_cu); per_cu = 1; }
        grid = (cus > 0 ? cus : 256);
        (void)hipGetLastError();
    }
    Args a{};
    const float** f = (const float**)&a.p;
    for (int i = 0; i < 21; ++i) f[i] = (const float*)d_in[i];
    a.p.out = (float*)d_out; a.p.ws = (unsigned char*)d_ws;
#if MK_PER_PHASE
    for (int k = 0; k < PH_COUNT; ++k) { a.ph_lo = k; a.ph_hi = k + 1; hipLaunchKernelGGL(mega, dim3(grid), dim3(NWAVES * 64), LDS_BYTES, stream, a); }
#else
    a.ph_lo = 0; a.ph_hi = PH_COUNT;
    void* args[] = {&a};
    hipError_t e = hipLaunchCooperativeKernel((const void*)mega, dim3(grid), dim3(NWAVES * 64), args, LDS_BYTES, stream);
    if (e != hipSuccess) fprintf(stderr, "kernel_launch: cooperative launch failed: %s (grid %d)\n", hipGetErrorString(e), grid);
#endif
}
```
